# Optimizing an MI355X kernel written in HIP

```python
import math
import jax
import jax.numpy as jnp
from jax import lax
import numpy as np

D_MODEL = 2048
BATCH = 2
SEQ = 4096
DEPTH = 4

GRID_W = 64
CTX_LEN = 256
EPS = 1e-6
ROPE_BASE = 10000.0
BLOCK = 128

GROUP_WIDTH = D_MODEL // 4
MIX_WIDTH = 4 * GROUP_WIDTH
N_MOD = 6

A_HEADS = 8
A_KV_HEADS = 2
A_HEAD_DIM = GROUP_WIDTH // A_HEADS
WINDOW = 128

HY_WIDTH = GROUP_WIDTH
HY_ORDER = 2
HY_SHORT = 3
HY_POS_FREQS = 8
HY_POS_DIM = 1 + 2 * HY_POS_FREQS
HY_FILTER_HIDDEN = 64
HY_DECAY_TARGET = 1e-2
HY_FAST_DECAY = 0.3
HY_SLOW_DECAY = 1.5

ML_HEADS = 4
ML_HEAD_DIM = GROUP_WIDTH // ML_HEADS
ML_CHUNK = 128

MLA_HEADS = 8
MLA_Q_RANK = D_MODEL // 4
MLA_KV_RANK = D_MODEL // 8
MLA_NOPE = 64
MLA_ROPE = 32
MLA_V = GROUP_WIDTH // MLA_HEADS

FFN_DIM = 5632
N_EXPERTS = 8
TOP_K = 2
EXPERT_DIM = FFN_DIM // TOP_K

IN_SPLITS = (A_HEADS * A_HEAD_DIM, A_KV_HEADS * A_HEAD_DIM, A_KV_HEADS * A_HEAD_DIM,
             (HY_ORDER + 1) * HY_WIDTH,
             GROUP_WIDTH, GROUP_WIDTH, GROUP_WIDTH, GROUP_WIDTH, 4 * ML_HEADS,
             MLA_Q_RANK, MLA_KV_RANK, MLA_ROPE)
IN_WIDTH = sum(IN_SPLITS)
N_DENSE = (DEPTH + 1) // 2
N_MOE = DEPTH // 2

kernel_name = 'hybrid_parallel_head_diffusion_trunk'


def rmsnorm(x, g):
    xf = x.astype(jnp.float32)
    y = xf * lax.rsqrt(jnp.mean(xf * xf, axis=-1, keepdims=True) + EPS)
    return (y * g.astype(jnp.float32)).astype(x.dtype)


def modulate(h, shift, scale):
    return h * (1 + scale) + shift


def split_cols(p):
    return jnp.split(p, np.cumsum(IN_SPLITS)[:-1].tolist(), axis=-1)


def merge_heads(o):
    b, h, n, d = o.shape
    return o.transpose(0, 2, 1, 3).reshape(b, n, h * d)


def swiglu(h, w_gate, w_up, w_down):
    return (jax.nn.silu(h @ w_gate) * (h @ w_up)) @ w_down


def axial_angles(rows, rot_dim):
    r = jnp.repeat(jnp.arange(rows, dtype=jnp.float32), GRID_W)
    col = jnp.tile(jnp.arange(GRID_W, dtype=jnp.float32), rows)
    half = rot_dim // 2
    inv = ROPE_BASE ** (-jnp.arange(0, half, 2, dtype=jnp.float32) / half)
    return r[:, None] * inv, col[:, None] * inv


def _rotate(x, ang):
    x1, x2 = jnp.split(x, 2, axis=-1)
    cos, sin = jnp.cos(ang), jnp.sin(ang)
    return jnp.concatenate([x1 * cos - x2 * sin, x2 * cos + x1 * sin], axis=-1)


def apply_axial_rope(x, ang):
    ang_r, ang_c = ang
    xf = x.astype(jnp.float32)
    half = xf.shape[-1] // 2
    out = jnp.concatenate([_rotate(xf[..., :half], ang_r), _rotate(xf[..., half:], ang_c)], axis=-1)
    return out.astype(x.dtype)


def dense_attend(q, k, v, scale):
    s = jnp.einsum('bhqd,bhkd->bhqk', q, k).astype(jnp.float32) * scale
    return jnp.einsum('bhqk,bhkd->bhqd', jax.nn.softmax(s, axis=-1).astype(v.dtype), v)


def window_gqa(q_l, k_l, v_l, q_c, k_c, v_c, sink, ang, with_ctx_out):
    groups = A_HEADS // A_KV_HEADS
    scale = A_HEAD_DIM ** -0.5

    def heads(t, nh):
        b_, n_, _ = t.shape
        return t.reshape(b_, n_, nh, A_HEAD_DIM).transpose(0, 2, 1, 3)

    q = apply_axial_rope(heads(q_l, A_HEADS), ang)
    k = apply_axial_rope(heads(k_l, A_KV_HEADS), ang)
    v = heads(v_l, A_KV_HEADS)
    kc, vc = heads(k_c, A_KV_HEADS), heads(v_c, A_KV_HEADS)
    b, _, n, d = q.shape
    nb = n // BLOCK
    n_ctx = kc.shape[2]
    qb = q.reshape(b, A_KV_HEADS, groups, nb, BLOCK, d)

    def band(t):
        tp = jnp.pad(t, ((0, 0), (0, 0), (BLOCK, BLOCK), (0, 0))).reshape(b, A_KV_HEADS, nb + 2, BLOCK, d)
        return jnp.concatenate([tp[:, :, :-2], tp[:, :, 1:-1], tp[:, :, 2:]], axis=3)

    kb, vb = band(k), band(v)
    qi = jnp.arange(BLOCK)[:, None]
    kj = jnp.arange(3 * BLOCK)[None, :]
    k_abs = jnp.arange(nb)[:, None, None] * BLOCK - BLOCK + kj[None]
    valid = (jnp.abs(kj - BLOCK - qi) <= WINDOW)[None] & (k_abs >= 0) & (k_abs < n)
    s_band = jnp.where(valid, jnp.einsum('bkgnqd,bknjd->bkgnqj', qb, kb).astype(jnp.float32) * scale, -jnp.inf)
    s_ctx = jnp.einsum('bkgnqd,bkcd->bkgnqc', qb, kc).astype(jnp.float32) * scale
    sink_col = jnp.broadcast_to(sink.astype(jnp.float32).reshape(A_KV_HEADS, groups, 1, 1, 1), s_ctx.shape[:-1] + (1,))
    p = jax.nn.softmax(jnp.concatenate([s_band, s_ctx, sink_col], axis=-1), axis=-1).astype(v.dtype)
    o = (jnp.einsum('bkgnqj,bknjd->bkgnqd', p[..., :3 * BLOCK], vb)
         + jnp.einsum('bkgnqc,bkcd->bkgnqd', p[..., 3 * BLOCK:3 * BLOCK + n_ctx], vc))
    out_l = merge_heads(o.reshape(b, A_HEADS, n, d))
    out_c = None
    if with_ctx_out:
        qc = heads(q_c, A_HEADS).reshape(b, A_KV_HEADS, groups, n_ctx, d)
        s = jnp.einsum('bkgqd,bkcd->bkgqc', qc, kc).astype(jnp.float32) * scale
        sink_c = jnp.broadcast_to(sink.astype(jnp.float32).reshape(A_KV_HEADS, groups, 1, 1), s.shape[:-1] + (1,))
        pc = jax.nn.softmax(jnp.concatenate([s, sink_c], axis=-1), axis=-1)[..., :n_ctx].astype(vc.dtype)
        out_c = merge_heads(jnp.einsum('bkgqc,bkcd->bkgqd', pc, vc).reshape(b, A_HEADS, n_ctx, d))
    return out_l, out_c


def hyena_filter_spectrum(L, w1, b1, w2, b2, freq, w3):
    f32 = jnp.float32
    t = jnp.arange(L, dtype=f32) / L
    kf = jnp.arange(1, HY_POS_FREQS + 1, dtype=f32)
    ang = 2.0 * math.pi * t[:, None] * kf
    feats = jnp.concatenate([t[:, None], jnp.sin(ang), jnp.cos(ang)], axis=-1)
    fr = freq.astype(f32)
    hdn = jnp.sin(fr * (feats @ w1.astype(f32) + b1.astype(f32)))
    hdn = jnp.sin(fr * (hdn @ w2.astype(f32) + b2.astype(f32)))
    h = (hdn @ w3.astype(f32)).reshape(L, HY_ORDER, 2, HY_WIDTH)
    deltas = jnp.abs(jnp.linspace(math.log(HY_DECAY_TARGET) / HY_SLOW_DECAY,
                                  math.log(HY_DECAY_TARGET) / HY_FAST_DECAY, HY_WIDTH, dtype=f32))
    h = h * jnp.exp(-t[:, None] * deltas)[:, None, None, :]
    g = jnp.concatenate([h[:, :, 0], jnp.zeros((1, HY_ORDER, HY_WIDTH), f32), h[:0:-1, :, 1]], axis=0)
    g = g / jnp.sum(jnp.abs(g), axis=0, keepdims=True)
    return jnp.fft.rfft(g, axis=0)


def fft_long_conv(z, spec):
    L = z.shape[1]
    zf = jnp.fft.rfft(z.astype(jnp.float32), n=2 * L, axis=1)
    return jnp.fft.irfft(zf * spec, n=2 * L, axis=1)[:, :L].astype(z.dtype)


def hyena_mixer(p_l, p_c, short_w, w1, b1, w2, b2, freq, w3, bias, with_ctx_out):
    def run(p):
        L = p.shape[1]
        pad = HY_SHORT // 2
        pp = jnp.pad(p, ((0, 0), (pad, pad), (0, 0)))
        u = sum(short_w[j] * pp[:, j:j + L] for j in range(HY_SHORT))
        v, *gates = jnp.split(u, HY_ORDER + 1, axis=-1)
        spec = hyena_filter_spectrum(L, w1, b1, w2, b2, freq, w3)
        z = v
        for o_i, xg in enumerate(gates):
            z = xg * (fft_long_conv(z, spec[:, o_i]) + bias[o_i] * z)
        return z
    return run(p_l), (run(p_c) if with_ctx_out else None)


def mlstm_chunkwise(q, k, v, li, lf, state):
    b, nh, L, d = q.shape
    nc = L // ML_CHUNK

    def chunks(t):
        return jnp.moveaxis(t.reshape(b, nh, nc, ML_CHUNK, *t.shape[3:]), 2, 0)

    lower = jnp.tril(jnp.ones((ML_CHUNK, ML_CHUNK), dtype=bool))

    def step(carry, inp):
        C, nvec, m = carry
        qc, kc, vc, lic, lfc = inp
        cum = jnp.cumsum(lfc, axis=-1)
        log_intra = jnp.where(lower, cum[..., :, None] - cum[..., None, :] + lic[..., None, :], -jnp.inf)
        log_inter = cum + m[..., None]
        m_t = jnp.maximum(log_inter, jnp.max(log_intra, axis=-1))
        w_inter = jnp.exp(log_inter - m_t)
        s = jnp.einsum('bhtd,bhsd->bhts', qc, kc) * jnp.exp(log_intra - m_t[..., None])
        num = w_inter[..., None] * jnp.einsum('bhvd,bhtd->bhtv', C, qc) + jnp.einsum('bhts,bhsv->bhtv', s, vc)
        den = w_inter * jnp.einsum('bhd,bhtd->bht', nvec, qc) + jnp.sum(s, axis=-1)
        h = num / jnp.maximum(jnp.abs(den), jnp.exp(-m_t))[..., None]
        total = cum[..., -1]
        log_w = total[..., None] - cum + lic
        m_new = jnp.maximum(total + m, jnp.max(log_w, axis=-1))
        carry_decay = jnp.exp(total + m - m_new)
        w = jnp.exp(log_w - m_new[..., None])
        C_new = carry_decay[..., None, None] * C + jnp.einsum('bhs,bhsv,bhsd->bhvd', w, vc, kc)
        n_new = carry_decay[..., None] * nvec + jnp.einsum('bhs,bhsd->bhd', w, kc)
        return (C_new, n_new, m_new), h

    state, h = lax.scan(step, state, (chunks(q), chunks(k), chunks(v), chunks(li), chunks(lf)))
    return jnp.moveaxis(h, 0, 2).reshape(b, nh, L, d), state


def mlstm_mixer(parts_l, parts_c, gate_bias, out_norm, with_ctx_out):
    f32 = jnp.float32

    def prep(q, k, v, o, g):
        b_, n_, _ = q.shape
        heads = lambda t: t.astype(f32).reshape(b_, n_, ML_HEADS, ML_HEAD_DIM).transpose(0, 2, 1, 3)
        gates = (g.astype(f32).reshape(b_, n_, 4, ML_HEADS) + gate_bias.astype(f32)).transpose(2, 0, 3, 1)
        return heads(q), heads(k) * ML_HEAD_DIM ** -0.5, heads(v), gates

    def both_directions(q, k, v, gates, state_f, state_b):
        flip = lambda t: jnp.flip(t, axis=2)
        h_f, end_f = mlstm_chunkwise(q, k, v, gates[0], jax.nn.log_sigmoid(gates[1]), state_f)
        h_b, end_b = mlstm_chunkwise(flip(q), flip(k), flip(v), flip(gates[2]),
                                     flip(jax.nn.log_sigmoid(gates[3])), state_b)
        return h_f + flip(h_b), end_f, end_b

    def finish(h, o):
        h = merge_heads(rmsnorm(h, out_norm.reshape(ML_HEADS, 1, ML_HEAD_DIM)))
        return (jax.nn.sigmoid(o.astype(f32)) * h).astype(o.dtype)

    qc, kc, vc, gc = prep(*parts_c)
    b = qc.shape[0]
    zero = (jnp.zeros((b, ML_HEADS, ML_HEAD_DIM, ML_HEAD_DIM), f32),
            jnp.zeros((b, ML_HEADS, ML_HEAD_DIM), f32), jnp.zeros((b, ML_HEADS), f32))
    h_c, end_f, end_b = both_directions(qc, kc, vc, gc, zero, zero)
    h_l, _, _ = both_directions(*prep(*parts_l), end_f, end_b)
    out_c = finish(h_c, parts_c[3]) if with_ctx_out else None
    return finish(h_l, parts_l[3]), out_c


def mla_mixer(parts_l, parts_c, q_norm, w_uq, kv_norm, w_ukv, ang, with_ctx_out):
    scale = (MLA_NOPE + MLA_ROPE) ** -0.5

    def queries(q_lat, rope):
        b_, n_, _ = q_lat.shape
        q = (rmsnorm(q_lat, q_norm) @ w_uq).reshape(b_, n_, MLA_HEADS, MLA_NOPE + MLA_ROPE).transpose(0, 2, 1, 3)
        q_rope = apply_axial_rope(q[..., MLA_NOPE:], ang) if rope else q[..., MLA_NOPE:]
        return jnp.concatenate([q[..., :MLA_NOPE], q_rope], axis=-1)

    def keys_values(kv_lat, k_rope, rope):
        b_, n_, _ = kv_lat.shape
        kv = (rmsnorm(kv_lat, kv_norm) @ w_ukv).reshape(b_, n_, MLA_HEADS, MLA_NOPE + MLA_V).transpose(0, 2, 1, 3)
        k_rope = k_rope[:, None]
        if rope:
            k_rope = apply_axial_rope(k_rope, ang)
        k = jnp.concatenate([kv[..., :MLA_NOPE], jnp.broadcast_to(k_rope, (b_, MLA_HEADS, n_, MLA_ROPE))], axis=-1)
        return k, kv[..., MLA_NOPE:]

    q_l = queries(parts_l[0], True)
    k_l, v_l = keys_values(parts_l[1], parts_l[2], True)
    k_c, v_c = keys_values(parts_c[1], parts_c[2], False)
    k_all = jnp.concatenate([k_l, k_c], axis=2)
    v_all = jnp.concatenate([v_l, v_c], axis=2)
    b, nh, n, dq = q_l.shape
    nb = n // BLOCK
    q_blocks = jnp.moveaxis(q_l.reshape(b, nh, nb, BLOCK, dq), 2, 0)
    o = lax.map(lambda qb: dense_attend(qb, k_all, v_all, scale), q_blocks)
    out_l = merge_heads(jnp.moveaxis(o, 0, 2).reshape(b, nh, n, MLA_V))
    out_c = merge_heads(dense_attend(queries(parts_c[0], False), k_c, v_c, scale)) if with_ctx_out else None
    return out_l, out_c


def moe_swiglu(h, router, w_gate, w_up, w_down):
    logits = (h @ router).astype(jnp.float32)
    top_val, top_idx = lax.top_k(logits, TOP_K)
    weights = jax.nn.softmax(top_val, axis=-1)
    combine = jnp.einsum('btk,btke->bte', weights,
                         jax.nn.one_hot(top_idx, N_EXPERTS, dtype=jnp.float32)).astype(h.dtype)
    return sum(combine[..., e:e + 1] * swiglu(h, w_gate[e], w_up[e], w_down[e]) for e in range(N_EXPERTS))


def setup_inputs(seed: int = 0) -> dict:
    key = jax.random.key(seed)
    keys = iter(jax.random.split(key, 40))

    def nrm(shape, scale):
        return scale * jax.random.normal(next(keys), shape, jnp.float32)

    def gain(shape):
        return 1.0 + nrm(shape, 0.05)

    D = D_MODEL
    HID = HY_FILTER_HIDDEN
    return {
        'x': nrm((BATCH, SEQ, D), 1.0),
        'c': nrm((BATCH, D), 1.0),
        'ctx': nrm((BATCH, CTX_LEN, D), 1.0),
        'c_ctx': nrm((D,), 1.0),
        'w_mod': nrm((DEPTH, D, N_MOD * D), 0.5 * D ** -0.5),
        'b_mod': nrm((DEPTH, N_MOD * D), 0.02),
        'g_mix_pre': gain((DEPTH, D)),
        'g_mix_post': gain((DEPTH, D)),
        'g_ffn_pre': gain((DEPTH, D)),
        'g_ffn_post': gain((DEPTH, D)),
        'w_in': nrm((DEPTH, D, IN_WIDTH), D ** -0.5),
        'w_out': nrm((DEPTH, MIX_WIDTH, D), MIX_WIDTH ** -0.5),
        'attn_sink': nrm((DEPTH, A_HEADS), 1.0),
        'hy_short': nrm((DEPTH, HY_SHORT, (HY_ORDER + 1) * HY_WIDTH), HY_SHORT ** -0.5),
        'hy_w1': nrm((DEPTH, HY_POS_DIM, HID), HY_POS_DIM ** -0.5),
        'hy_b1': nrm((DEPTH, HID), 0.1),
        'hy_w2': nrm((DEPTH, HID, HID), HID ** -0.5),
        'hy_b2': nrm((DEPTH, HID), 0.1),
        'hy_freq': gain((DEPTH, HID)),
        'hy_w3': nrm((DEPTH, HID, HY_ORDER * 2 * HY_WIDTH), HID ** -0.5),
        'hy_bias': nrm((DEPTH, HY_ORDER, HY_WIDTH), 1.0),
        'ml_gate_bias': nrm((DEPTH, 4, ML_HEADS), 0.3) + jnp.array([0.0, 3.0, 0.0, 3.0], jnp.float32)[None, :, None],
        'ml_norm': gain((DEPTH, GROUP_WIDTH)),
        'mla_q_norm': gain((DEPTH, MLA_Q_RANK)),
        'mla_w_uq': nrm((DEPTH, MLA_Q_RANK, MLA_HEADS * (MLA_NOPE + MLA_ROPE)), MLA_Q_RANK ** -0.5),
        'mla_kv_norm': gain((DEPTH, MLA_KV_RANK)),
        'mla_w_ukv': nrm((DEPTH, MLA_KV_RANK, MLA_HEADS * (MLA_NOPE + MLA_V)), MLA_KV_RANK ** -0.5),
        'ffn_w_gate': nrm((N_DENSE, D, FFN_DIM), D ** -0.5),
        'ffn_w_up': nrm((N_DENSE, D, FFN_DIM), D ** -0.5),
        'ffn_w_down': nrm((N_DENSE, FFN_DIM, D), FFN_DIM ** -0.5),
        'moe_router': nrm((N_MOE, D, N_EXPERTS), D ** -0.5),
        'moe_w_gate': nrm((N_MOE, N_EXPERTS, D, EXPERT_DIM), D ** -0.5),
        'moe_w_up': nrm((N_MOE, N_EXPERTS, D, EXPERT_DIM), D ** -0.5),
        'moe_w_down': nrm((N_MOE, N_EXPERTS, EXPERT_DIM, D), EXPERT_DIM ** -0.5),
    }


def reference(x, c, ctx, c_ctx, w_mod, b_mod, g_mix_pre, g_mix_post, g_ffn_pre, g_ffn_post,
              w_in, w_out, attn_sink, hy_short, hy_w1, hy_b1, hy_w2, hy_b2, hy_freq, hy_w3, hy_bias,
              ml_gate_bias, ml_norm, mla_q_norm, mla_w_uq, mla_kv_norm, mla_w_ukv,
              ffn_w_gate, ffn_w_up, ffn_w_down, moe_router, moe_w_gate, moe_w_up, moe_w_down):
    rows = x.shape[1] // GRID_W
    ang_a = axial_angles(rows, A_HEAD_DIM)
    ang_m = axial_angles(rows, MLA_ROPE)

    def channel_mix(h, layer):
        i = layer // 2
        if layer % 2 == 0:
            return swiglu(h, ffn_w_gate[i], ffn_w_up[i], ffn_w_down[i])
        return moe_swiglu(h, moe_router[i], moe_w_gate[i], moe_w_up[i], moe_w_down[i])

    x_lat, x_ctx = x, ctx
    for layer in range(DEPTH):
        ctx_out = layer < DEPTH - 1
        mod_l = jnp.split((jax.nn.silu(c) @ w_mod[layer] + b_mod[layer])[:, None, :], N_MOD, axis=-1)
        mod_c = jnp.split((jax.nn.silu(c_ctx) @ w_mod[layer] + b_mod[layer])[None, None, :], N_MOD, axis=-1)

        pl = split_cols(modulate(rmsnorm(x_lat, g_mix_pre[layer]), mod_l[0], mod_l[1]) @ w_in[layer])
        pc = split_cols(modulate(rmsnorm(x_ctx, g_mix_pre[layer]), mod_c[0], mod_c[1]) @ w_in[layer])
        a_l, a_c = window_gqa(pl[0], pl[1], pl[2], pc[0], pc[1], pc[2], attn_sink[layer], ang_a, ctx_out)
        b_l, b_c = hyena_mixer(pl[3], pc[3], hy_short[layer], hy_w1[layer], hy_b1[layer], hy_w2[layer],
                               hy_b2[layer], hy_freq[layer], hy_w3[layer], hy_bias[layer], ctx_out)
        m_l, m_c = mlstm_mixer(pl[4:9], pc[4:9], ml_gate_bias[layer], ml_norm[layer], ctx_out)
        d_l, d_c = mla_mixer(pl[9:12], pc[9:12], mla_q_norm[layer], mla_w_uq[layer], mla_kv_norm[layer],
                             mla_w_ukv[layer], ang_m, ctx_out)
        y_l = jnp.concatenate([a_l, b_l, m_l, d_l], axis=-1) @ w_out[layer]
        x_lat = x_lat + mod_l[2] * rmsnorm(y_l, g_mix_post[layer])

        h_l = modulate(rmsnorm(x_lat, g_ffn_pre[layer]), mod_l[3], mod_l[4])
        x_lat = x_lat + mod_l[5] * rmsnorm(channel_mix(h_l, layer), g_ffn_post[layer])

        if ctx_out:
            y_c = jnp.concatenate([a_c, b_c, m_c, d_c], axis=-1) @ w_out[layer]
            x_ctx = x_ctx + mod_c[2] * rmsnorm(y_c, g_mix_post[layer])
            h_c = modulate(rmsnorm(x_ctx, g_ffn_pre[layer]), mod_c[3], mod_c[4])
            x_ctx = x_ctx + mod_c[5] * rmsnorm(channel_mix(h_c, layer), g_ffn_post[layer])
    return x_lat
```

```cpp
#include <hip/hip_runtime.h>
#include <cstdio>
#include <cstdint>

#define DI __device__ __forceinline__
#define LAS __attribute__((address_space(3)))
__device__ __forceinline__ int mk_otid() { int t = (int)threadIdx.x; asm volatile("" : "+v"(t)); return t; }
__device__ __forceinline__ float mk_shx(float v, int mask) { int lane = (int)__builtin_amdgcn_mbcnt_hi(~0u, __builtin_amdgcn_mbcnt_lo(~0u, 0u)); asm volatile("" : "+v"(lane)); return __int_as_float(__builtin_amdgcn_ds_bpermute((lane ^ mask) << 2, __float_as_int(v))); }

namespace pg8 {
#define PG8_LAS __attribute__((address_space(3)))
typedef unsigned short bf16_t;
typedef short bf16x8 __attribute__((ext_vector_type(8)));
typedef float f32x4 __attribute__((ext_vector_type(4)));
typedef unsigned u32x4 __attribute__((ext_vector_type(4)));
constexpr int BM = 256, BK = 64, HALF = 128, HTB = HALF * BK * 2  , STAGE_BYTES = 8 * HTB, NXCD = 8, WGM = 8;

__host__ __device__ __forceinline__ int lds_byte(int r, int c) { const int st = (r >> 4) * 2 + (c >> 5), rr = r & 15, cc = c & 31, ob = rr * 64 + cc * 2; return st * 1024 + (ob ^ (((ob >> 9) & 1) << 5)); }
__host__ __device__ __forceinline__ void stage_rc(int b, int& R, int& C) { const int st = b / 1024, sb = b % 1024, swz = sb ^ (((sb >> 9) & 1) << 5); R = (st >> 1) * 16 + swz / 64; C = (st & 1) * 32 + (swz % 64) / 2; }
__host__ __device__ __forceinline__ int perm32(int rho) { const int n = rho >> 4, i = rho & 15; return 8 * (i >> 2) + 4 * n + (i & 3); }

struct Unit { int pm, pn, ko, ks; };
struct Gemm { const bf16_t* A; const bf16_t* Bt; int M, N, K, ld; int sa, sb; };

struct StaticOrder {
    int nM, nN, nwg, G, c;
    __host__ __device__ void init(int M, int N, int G_, int c_) { nM = M / BM; nN = N / BM; nwg = nM * nN; G = G_; c = c_; }
    __host__ __device__ bool next(int i, Unit& u) const {
        const long L = (long)i * G + c; if (L >= nwg) return false;
        int wgid = (int)L; { const int q = nwg / NXCD, r = nwg % NXCD, xcd = wgid % NXCD, off = wgid / NXCD; wgid = (xcd < r ? xcd * (q + 1) : r * (q + 1) + (xcd - r) * q) + off; }
        const int nig = WGM * nN, gid = wgid / nig, fm = gid * WGM, gsz = (nM - fm) < WGM ? (nM - fm) : WGM;
        u.pm = fm + ((wgid % nig) % gsz); u.pn = (wgid % nig) / gsz; u.ko = 0; u.ks = 0; return true;
    }
    __device__ __forceinline__ void a_ready(const Unit&) const {}
    __device__ __forceinline__ void done(const Unit&) const {}
};
struct SplitOrder {
    int nM, nN, ns, kb, G, c;
    __device__ __forceinline__ bool next(int i, Unit& u) const {
        const int L = i * G + c, nt = nM * nN; if (L >= nt * ns) return false;
        const int s = L / nt, t = L % nt; u.pm = t / nN; u.pn = t % nN; u.ks = s; u.ko = s * kb; return true;
    }
    __device__ __forceinline__ void a_ready(const Unit&) const {}
    __device__ __forceinline__ void done(const Unit&) const {}
};
struct GroupedOrder {
    int nM, nN, nwg, G, c; int s1, s2, s3, s4, s5, s6, s7;
    __device__ __forceinline__ bool next(int i, Unit& u) const {
        const long L = (long)i * G + c; if (L >= nwg) return false;
        int wgid = (int)L; { const int q = nwg / NXCD, r = nwg % NXCD, xcd = wgid % NXCD, off = wgid / NXCD; wgid = (xcd < r ? xcd * (q + 1) : r * (q + 1) + (xcd - r) * q) + off; }
        const int nig = WGM * nN, gid = wgid / nig, fm = gid * WGM, gsz = (nM - fm) < WGM ? (nM - fm) : WGM;
        const int pm = fm + ((wgid % nig) % gsz), pl = (wgid % nig) / gsz;
        const int e = (pm >= s1) + (pm >= s2) + (pm >= s3) + (pm >= s4) + (pm >= s5) + (pm >= s6) + (pm >= s7);
        u.pm = pm; u.pn = e * nN + pl; u.ko = 0; u.ks = 0; return true;
    }
    __device__ __forceinline__ void a_ready(const Unit&) const {}
    __device__ __forceinline__ void done(const Unit&) const {}
};

typedef float f32x2_t __attribute__((ext_vector_type(2))); typedef __bf16 bf16x2_t __attribute__((ext_vector_type(2)));
__device__ __forceinline__ unsigned cvt_pk_bf16(float lo, float hi) { f32x2_t v = {lo, hi}; bf16x2_t b = __builtin_convertvector(v, bf16x2_t); return __builtin_bit_cast(unsigned, b); }

struct EpiStore {
    static constexpr bool PERM = true, AFTER_DRAIN = false;
    bf16_t* O; int ldc; int nct; size_t sstride;
    __device__ __forceinline__ void operator()(const f32x4 (&acc)[2][2][4][2], const Unit& u, int wr, int wc, int fr, int fq) const {
        const int row0 = u.pm * BM + wr * 64 + fr; const int col0 = (u.pn % nct) * BM + wc * 32 + 8 * fq;
        bf16_t* Ob = O + (size_t)u.ks * sstride;
#pragma unroll
        for (int ai = 0; ai < 2; ++ai)
#pragma unroll
            for (int m = 0; m < 4; ++m) { bf16_t* rowp = Ob + (size_t)(row0 + ai * HALF + m * 16) * ldc + col0;
#pragma unroll
                for (int bj = 0; bj < 2; ++bj) { const f32x4 v0 = acc[ai][bj][m][0], v1 = acc[ai][bj][m][1];
                    u32x4 w; w.x = cvt_pk_bf16(v0[0], v0[1]); w.y = cvt_pk_bf16(v0[2], v0[3]); w.z = cvt_pk_bf16(v1[0], v1[1]); w.w = cvt_pk_bf16(v1[2], v1[3]);
                    *(u32x4*)(rowp + bj * HALF) = w; } }
    }
};
struct EpiSwiGLU {
    static constexpr bool PERM = true, AFTER_DRAIN = false;
    bf16_t* H; int ldh; int nct; int f8;
    __device__ __forceinline__ void operator()(const f32x4 (&acc)[2][2][4][2], const Unit& u, int wr, int wc, int fr, int fq) const {
        const int row0 = u.pm * BM + wr * 64 + fr; const int col0 = (u.pn % nct) * HALF + wc * 32 + 8 * fq;
#pragma unroll
        for (int ai = 0; ai < 2; ++ai)
#pragma unroll
            for (int m = 0; m < 4; ++m) { bf16_t* rowp = H + (size_t)(row0 + ai * HALF + m * 16) * ldh + col0;
                float h[8];
#pragma unroll
                for (int n = 0; n < 2; ++n)
#pragma unroll
                    for (int e = 0; e < 4; ++e) { const float g = acc[ai][0][m][n][e], up = acc[ai][1][m][n][e];
                        h[n * 4 + e] = g * __builtin_amdgcn_rcpf(1.0f + __expf(-g)) * up; }
                if (f8) { float c8[8];
#pragma unroll
                    for (int i = 0; i < 8; ++i) c8[i] = fminf(fmaxf(h[i] * 8.0f, -448.0f), 448.0f);
                    int p0 = __builtin_amdgcn_cvt_pk_fp8_f32(c8[0], c8[1], 0, false); p0 = __builtin_amdgcn_cvt_pk_fp8_f32(c8[2], c8[3], p0, true);
                    int p1 = __builtin_amdgcn_cvt_pk_fp8_f32(c8[4], c8[5], 0, false); p1 = __builtin_amdgcn_cvt_pk_fp8_f32(c8[6], c8[7], p1, true);
                    typedef unsigned pg8_u2 __attribute__((ext_vector_type(2)));
                    *(pg8_u2*)((unsigned char*)H + (size_t)(row0 + ai * HALF + m * 16) * ldh + col0) = (pg8_u2){(unsigned)p0, (unsigned)p1}; }
                else { u32x4 w; w.x = cvt_pk_bf16(h[0], h[1]); w.y = cvt_pk_bf16(h[2], h[3]); w.z = cvt_pk_bf16(h[4], h[5]); w.w = cvt_pk_bf16(h[6], h[7]);
                    *(u32x4*)rowp = w; } }
    }
};
struct EpiKV {
    static constexpr bool PERM = true, AFTER_DRAIN = false;
    bf16_t* KN; bf16_t* VT; int ldt;
    __device__ __forceinline__ void operator()(const f32x4 (&acc)[2][2][4][2], const Unit& u, int wr, int wc, int fr, int fq) const {
        const int row0 = u.pm * BM + wr * 64 + fr;
        if (u.pn < 2) {
            const int col0 = u.pn * BM + wc * 32 + 8 * fq;
#pragma unroll
            for (int ai = 0; ai < 2; ++ai)
#pragma unroll
                for (int m = 0; m < 4; ++m) { bf16_t* rowp = KN + (size_t)(row0 + ai * HALF + m * 16) * 512 + col0;
#pragma unroll
                    for (int bj = 0; bj < 2; ++bj) { const f32x4 v0 = acc[ai][bj][m][0], v1 = acc[ai][bj][m][1];
                        u32x4 w; w.x = cvt_pk_bf16(v0[0], v0[1]); w.y = cvt_pk_bf16(v0[2], v0[3]); w.z = cvt_pk_bf16(v1[0], v1[1]); w.w = cvt_pk_bf16(v1[2], v1[3]);
                        *(u32x4*)(rowp + bj * HALF) = w; } }
        } else {
            const int f0 = (u.pn - 2) * BM + wc * 32 + 8 * fq;
#pragma unroll
            for (int bj = 0; bj < 2; ++bj)
#pragma unroll
                for (int n = 0; n < 2; ++n)
#pragma unroll
                    for (int e = 0; e < 4; ++e) { bf16_t* cp = VT + (size_t)(f0 + bj * HALF + 4 * n + e) * ldt + row0;
#pragma unroll
                        for (int ai = 0; ai < 2; ++ai)
#pragma unroll
                            for (int m = 0; m < 4; ++m) cp[ai * HALF + m * 16] = (bf16_t)(cvt_pk_bf16(acc[ai][bj][m][n][e], 0.f) & 0xffffu);
                        asm volatile("" ::: "memory"); }
        }
    }
};

template <class Epi, class Sched, bool ALIGN_EPI = false, bool SP2 = false, int ES = 2>
__device__ __forceinline__ void gemm_phase(PG8_LAS unsigned char* lds, const Gemm g, const Sched& S, const Epi& E) {
    const int tid = mk_otid(), wid = __builtin_amdgcn_readfirstlane(tid >> 6), lane = tid & 63, wr = wid >> 2, wc = wid & 3, fr = lane & 15, fq = lane >> 4;
    const int K = g.K, nt = (K * ES) / (BK * 2), LD = g.ld ? g.ld : g.K;
    unsigned voffA[2], voffB[2];
#pragma unroll
    for (int i = 0; i < 2; ++i) { int R, C; stage_rc(tid * 16 + i * 8192, R, C); const int Rb = Epi::PERM ? ((R & ~31) + perm32(R & 31)) : R;
        voffA[i] = (unsigned)(R * LD * ES + C * 2); voffB[i] = (unsigned)(Rb * LD * ES + C * 2); }
    const size_t kstep = (size_t)(BK * 2);
    const size_t hstep = (size_t)HALF * LD * ES;
    const size_t tstep = 2 * hstep;
    const unsigned ldsw = (unsigned)wid * 1024u;
    const int aoff0 = ES == 2 ? lds_byte(wr * 64 + fr, fq * 8) : lds_byte(wr * 64 + fr, fq * 16), aoff1 = ES == 2 ? aoff0 + 1024 : lds_byte(wr * 64 + fr, fq * 16 + 8);
    const int boff0 = ES == 2 ? lds_byte(wc * 32 + fr, fq * 8) : lds_byte(wc * 32 + fr, fq * 16), boff1 = ES == 2 ? boff0 + 1024 : lds_byte(wc * 32 + fr, fq * 16 + 8);
#define PG8_SA(b, h) (((b) * 2 + (h)) * HTB)
#define PG8_SB(b, h) ((4 + (b) * 2 + (h)) * HTB)
#define PG8_STAGE(bufoff, gbase, voff) do { _Pragma("unroll") for (int _i = 0; _i < 2; ++_i) \
        __builtin_amdgcn_global_load_lds((const unsigned*)((const char*)(gbase) + (voff)[_i]), (PG8_LAS unsigned*)(lds + (bufoff) + ldsw + _i * 8192), 16, 0, 0); } while (0)
#define PG8_LD8(p0, p1) __builtin_shufflevector(*(const PG8_LAS pg8_v4i*)(p0), *(const PG8_LAS pg8_v4i*)(p1), 0, 1, 2, 3, 4, 5, 6, 7)
#define PG8_LDA(dst, b, h) do { if constexpr (ES == 2) { _Pragma("unroll") for (int m = 0; m < 4; ++m) _Pragma("unroll") for (int k = 0; k < 2; ++k) dst##2[m][k] = *(const PG8_LAS bf16x8*)(lds + PG8_SA(b, h) + (k ? aoff1 : aoff0) + m * 2048); } \
        else { _Pragma("unroll") for (int m = 0; m < 4; ++m) dst##8[m] = PG8_LD8(lds + PG8_SA(b, h) + aoff0 + m * 2048, lds + PG8_SA(b, h) + aoff1 + m * 2048); } } while (0)
#define PG8_LDB(dst, b, h) do { if constexpr (ES == 2) { _Pragma("unroll") for (int n = 0; n < 2; ++n) _Pragma("unroll") for (int k = 0; k < 2; ++k) dst##2[n][k] = *(const PG8_LAS bf16x8*)(lds + PG8_SB(b, h) + (k ? boff1 : boff0) + n * 2048); } \
        else { _Pragma("unroll") for (int n = 0; n < 2; ++n) dst##8[n] = PG8_LD8(lds + PG8_SB(b, h) + boff0 + n * 2048, lds + PG8_SB(b, h) + boff1 + n * 2048); } } while (0)
#define PG8_MMA(ai, bj, At, Bt) do { __builtin_amdgcn_s_setprio(1); _Pragma("unroll") for (int m = 0; m < 4; ++m) _Pragma("unroll") for (int n = 0; n < 2; ++n) { \
        if constexpr (ES == 2) { _Pragma("unroll") for (int k = 0; k < 2; ++k) acc[ai][bj][m][n] = __builtin_amdgcn_mfma_f32_16x16x32_bf16(Bt##2[n][k], At##2[m][k], acc[ai][bj][m][n], 0, 0, 0); } \
        else asm volatile("v_mfma_scale_f32_16x16x128_f8f6f4 %0, %1, %2, %0, %3, %4 op_sel_hi:[0,0,0]" : "+v"(acc[ai][bj][m][n]) : "v"(Bt##8[n]), "v"(At##8[m]), "v"(scw_), "v"(sca_)); } \
        __builtin_amdgcn_s_setprio(0); } while (0)
#define PG8_WAIT_V(n) asm volatile("s_waitcnt vmcnt(" #n ")" ::: "memory")
#define PG8_WAIT_L(n) asm volatile("s_waitcnt lgkmcnt(" #n ")" ::: "memory")
#define PG8_BAR __builtin_amdgcn_s_barrier()
#define PG8_SCHED __builtin_amdgcn_sched_barrier(0)
    Unit cur, nxt; int ui = 0;
    if (!S.next(0, cur)) return;
    f32x4 acc[2][2][4][2];
#pragma unroll
    for (int a = 0; a < 2; ++a)
#pragma unroll
        for (int b = 0; b < 2; ++b)
#pragma unroll
            for (int m = 0; m < 4; ++m)
#pragma unroll
                for (int n = 0; n < 2; ++n) acc[a][b][m][n] = (f32x4){0.f, 0.f, 0.f, 0.f};
    typedef int pg8_v4i __attribute__((ext_vector_type(4))); typedef int pg8_v8i __attribute__((ext_vector_type(8)));
    bf16x8 At2[4][2], B02[2][2], B12[2][2];
    pg8_v8i At8[4], B08[2], B18[2];
    const int scw_ = g.sb, sca_ = g.sa;
    const char* cA = (const char*)g.A + (size_t)cur.pm * tstep + cur.ko; const char* cB = (const char*)g.Bt + (size_t)cur.pn * tstep + cur.ko;
    S.a_ready(cur);
    if constexpr (SP2) {
        PG8_STAGE(PG8_SB(0, 0), cB, voffB); PG8_STAGE(PG8_SB(0, 1), cB + hstep, voffB); PG8_STAGE(PG8_SA(0, 0), cA, voffA); PG8_STAGE(PG8_SA(0, 1), cA + hstep, voffA);
        if (wr == 1) PG8_BAR;
        PG8_WAIT_V(2); PG8_BAR;
        PG8_STAGE(PG8_SB(1, 0), cB + kstep, voffB); PG8_STAGE(PG8_SA(1, 0), cA + kstep, voffA); PG8_STAGE(PG8_SB(1, 1), cB + hstep + kstep, voffB);
        PG8_WAIT_V(6); PG8_BAR;
    } else {
        PG8_STAGE(PG8_SB(0, 0), cB, voffB); PG8_STAGE(PG8_SA(0, 0), cA, voffA); PG8_STAGE(PG8_SB(0, 1), cB + hstep, voffB); PG8_STAGE(PG8_SA(0, 1), cA + hstep, voffA);
        if (wr == 1) PG8_BAR;
        PG8_WAIT_V(4); PG8_BAR;
        PG8_STAGE(PG8_SB(1, 0), cB + kstep, voffB); PG8_STAGE(PG8_SA(1, 0), cA + kstep, voffA); PG8_STAGE(PG8_SB(1, 1), cB + hstep + kstep, voffB);
        PG8_WAIT_V(6); PG8_BAR;
    }
    for (;;) {
        const bool has_next = S.next(ui + 1, nxt);
        const char* nA = has_next ? (const char*)g.A + (size_t)nxt.pm * tstep + nxt.ko : cA; const char* nB = has_next ? (const char*)g.Bt + (size_t)nxt.pn * tstep + nxt.ko : cB;
        for (int t = 0; t < nt; t += 2) {
            const bool last = (t == nt - 2);
            const char* a1 = cA + (size_t)(t + 1) * kstep;
            const char* a2 = last ? nA : cA + (size_t)(t + 2) * kstep; const char* b2 = last ? nB : cB + (size_t)(t + 2) * kstep;
            const char* a3 = a2 + kstep; const char* b3 = b2 + kstep;
            if (last && has_next) S.a_ready(nxt);
            if constexpr (SP2) {
            PG8_LDB(B0, 0, 0); PG8_LDB(B1, 0, 1); PG8_SCHED; PG8_LDA(At, 0, 0); PG8_STAGE(PG8_SA(1, 1), a1 + hstep, voffA);
            PG8_WAIT_V(8); PG8_WAIT_L(0); PG8_BAR; PG8_MMA(0, 0, At, B0); PG8_MMA(0, 1, At, B1); PG8_BAR; PG8_SCHED;
            PG8_LDA(At, 0, 1); PG8_STAGE(PG8_SB(0, 0), b2, voffB); PG8_STAGE(PG8_SB(0, 1), b2 + hstep, voffB); PG8_STAGE(PG8_SA(0, 0), a2, voffA);
            PG8_WAIT_V(8); PG8_WAIT_L(0); PG8_BAR; PG8_MMA(1, 0, At, B0); PG8_MMA(1, 1, At, B1); PG8_BAR; PG8_SCHED;
            PG8_LDB(B0, 1, 0); PG8_LDB(B1, 1, 1); PG8_SCHED; PG8_LDA(At, 1, 0); PG8_STAGE(PG8_SA(0, 1), a2 + hstep, voffA);
            PG8_WAIT_V(8); PG8_WAIT_L(0); PG8_BAR; PG8_MMA(0, 0, At, B0); PG8_MMA(0, 1, At, B1); PG8_BAR; PG8_SCHED;
            PG8_LDA(At, 1, 1); PG8_STAGE(PG8_SB(1, 0), b3, voffB); PG8_STAGE(PG8_SB(1, 1), b3 + hstep, voffB); PG8_STAGE(PG8_SA(1, 0), a3, voffA);
            PG8_WAIT_V(8); PG8_WAIT_L(0); PG8_BAR; PG8_MMA(1, 0, At, B0); PG8_MMA(1, 1, At, B1); PG8_BAR; PG8_SCHED;
            } else {
            PG8_LDB(B0, 0, 0); PG8_SCHED; PG8_LDA(At, 0, 0); PG8_STAGE(PG8_SA(1, 1), a1 + hstep, voffA);
            PG8_WAIT_L(8); PG8_BAR; PG8_WAIT_L(0); PG8_MMA(0, 0, At, B0); PG8_BAR; PG8_SCHED;
            PG8_LDB(B1, 0, 1); PG8_STAGE(PG8_SB(0, 0), b2, voffB);
            PG8_BAR; PG8_WAIT_L(0); PG8_MMA(0, 1, At, B1); PG8_BAR;
            PG8_LDA(At, 0, 1); PG8_STAGE(PG8_SA(0, 0), a2, voffA);
            PG8_BAR; PG8_WAIT_L(0); PG8_MMA(1, 0, At, B0); PG8_BAR; PG8_SCHED;
            PG8_STAGE(PG8_SB(0, 1), b2 + hstep, voffB);
            PG8_WAIT_V(6); PG8_BAR; PG8_MMA(1, 1, At, B1); PG8_BAR;
            PG8_LDB(B0, 1, 0); PG8_SCHED; PG8_LDA(At, 1, 0); PG8_STAGE(PG8_SA(0, 1), a2 + hstep, voffA);
            PG8_WAIT_L(8); PG8_BAR; PG8_WAIT_L(0); PG8_MMA(0, 0, At, B0); PG8_BAR; PG8_SCHED;
            PG8_LDB(B1, 1, 1); PG8_STAGE(PG8_SB(1, 0), b3, voffB);
            PG8_BAR; PG8_WAIT_L(0); PG8_MMA(0, 1, At, B1); PG8_BAR;
            PG8_LDA(At, 1, 1); PG8_STAGE(PG8_SA(1, 0), a3, voffA);
            PG8_BAR; PG8_WAIT_L(0); PG8_MMA(1, 0, At, B0); PG8_BAR; PG8_SCHED;
            PG8_STAGE(PG8_SB(1, 1), b3 + hstep, voffB);
            PG8_WAIT_V(6); PG8_BAR; PG8_MMA(1, 1, At, B1); PG8_BAR;
            }
        }
        if constexpr (ES == 1) asm volatile("s_nop 15\n\ts_nop 15" ::: "memory");
        if constexpr (ALIGN_EPI) { if (wr == 0) PG8_BAR; }
        if constexpr (!Epi::AFTER_DRAIN) { E(acc, cur, wr, wc, fr, fq); S.done(cur); }
        if (!has_next) break;
#pragma unroll
        for (int a = 0; a < 2; ++a)
#pragma unroll
            for (int b = 0; b < 2; ++b)
#pragma unroll
                for (int m = 0; m < 4; ++m)
#pragma unroll
                    for (int n = 0; n < 2; ++n) acc[a][b][m][n] = (f32x4){0.f, 0.f, 0.f, 0.f};
        cur = nxt; cA = nA; cB = nB; ++ui;
        if constexpr (ALIGN_EPI) { if (wr == 1) PG8_BAR; }
    }
    PG8_WAIT_V(0);
    if constexpr (!ALIGN_EPI) { if (wr == 0) PG8_BAR; }
    PG8_BAR;
    if constexpr (Epi::AFTER_DRAIN) { E.fused(acc, cur, wr, wc, fr, fq, lds, wid, lane); S.done(cur); }
#undef PG8_SA
#undef PG8_SB
#undef PG8_STAGE
#undef PG8_LDA
#undef PG8_LD8
#undef PG8_LDB
#undef PG8_MMA
#undef PG8_WAIT_V
#undef PG8_WAIT_L
#undef PG8_BAR
#undef PG8_SCHED
}
}

namespace mk {
typedef unsigned short bf16_t;
typedef short bf16x8 __attribute__((ext_vector_type(8)));
typedef float f32x4 __attribute__((ext_vector_type(4)));
typedef float f32x2 __attribute__((ext_vector_type(2)));
typedef float f32x16 __attribute__((ext_vector_type(16)));
typedef unsigned u32x4 __attribute__((ext_vector_type(4)));
typedef unsigned u32x2 __attribute__((ext_vector_type(2)));

constexpr int DM = 2048, NB = 2, SEQ = 4096, CTXL = 256, NLAT = NB * SEQ, NCTX = NB * CTXL, MROWS = NLAT + NCTX;
constexpr int DEPTH = 4, INW = 5168, INP = 5376, FFN = 5632, EXPD = 2816, NEXP = 8;
constexpr int OFF_AQ = 0, OFF_AK = 512, OFF_AV = 640, OFF_HY = 768, OFF_MQ = 2304, OFF_MK = 2816, OFF_MV = 3328, OFF_MO = 3840, OFF_MG = 4352, OFF_DQ = 4368, OFF_DKV = 4880, OFF_DKR = 5136;
constexpr int PT2_ROWS = 1664;
constexpr int MAXSLOT = 19456;
constexpr float EPS = 1e-6f, LOG2E = 1.4426950408889634f;
constexpr int NCHAIN = 16, NCHK = 34, CSTATE = 128 * 128 + 128;

constexpr size_t al256(size_t x) { return (x + 255) & ~(size_t)255; }
constexpr size_t WS_CTL = 0, CTL_BYTES = (size_t)2 << 20;
constexpr size_t WS_MOD = WS_CTL + CTL_BYTES;
constexpr size_t WS_ROPA = WS_MOD + al256((size_t)4 * 3 * 12288 * 4);
constexpr size_t WS_ROPM = WS_ROPA + al256((size_t)4096 * 32 * 8);
constexpr size_t WS_HDN = WS_ROPM + al256((size_t)4096 * 16 * 8);
constexpr size_t WS_FILT = WS_HDN + al256((size_t)4 * 4352 * 64 * 4);
constexpr size_t WS_FILTC = WS_FILT + al256((size_t)4 * 2 * 512 * 8192 * 2);
constexpr size_t WS_WIN = WS_FILTC + al256((size_t)4 * 2 * 512 * 512 * 4);
constexpr size_t WS_WOUT = WS_WIN + al256((size_t)4 * INP * DM * 2);
constexpr size_t WS_WGU = WS_WOUT + al256((size_t)4 * DM * DM * 2);
constexpr size_t WS_WDN = WS_WGU + al256((size_t)2 * 2 * FFN * DM * 2);
constexpr size_t WS_WGUE = WS_WDN + al256((size_t)2 * DM * FFN * 2);
constexpr size_t WS_WDNE = WS_WGUE + al256((size_t)2 * 8 * 2 * EXPD * DM * 2);
constexpr size_t WS_WUQ = WS_WDNE + al256((size_t)2 * 8 * DM * EXPD * 2);
constexpr size_t WS_WUKV = WS_WUQ + al256((size_t)4 * 768 * 512 * 2);
constexpr size_t WS_X = WS_WUKV + al256((size_t)4 * 1024 * 256 * 2);
constexpr size_t WS_HA = WS_X + al256((size_t)MROWS * DM * 4);
constexpr size_t WS_P = WS_HA + al256((size_t)MROWS * DM * 2);
constexpr size_t WS_PT2 = WS_P + al256((size_t)MROWS * INP * 2);
constexpr size_t WS_MIX = WS_PT2 + al256((size_t)PT2_ROWS * MROWS * 2);
constexpr size_t WS_Y = WS_MIX + al256((size_t)MROWS * DM * 2);
constexpr size_t WS_QN = WS_Y + al256((size_t)MROWS * DM * 2);
constexpr size_t WS_KVN = WS_QN + al256((size_t)MROWS * 512 * 2);
constexpr size_t WS_QU = WS_KVN + al256((size_t)MROWS * 256 * 2);
constexpr size_t WS_KN = WS_QU + al256((size_t)MROWS * 768 * 2);
constexpr size_t WS_VT = WS_KN + al256((size_t)MROWS * 512 * 2);
constexpr size_t WS_DC = WS_VT + al256((size_t)512 * MROWS * 2);
constexpr size_t WS_ML = WS_DC + al256((size_t)NCHAIN * NCHK * CSTATE * 4);
constexpr size_t WS_CIN = WS_ML + al256((size_t)NCHAIN * NCHK * 2 * 4);
constexpr size_t WS_NIN = WS_CIN + al256((size_t)NCHAIN * NCHK * 16384 * 2);
constexpr size_t WS_MIN = WS_NIN + al256((size_t)NCHAIN * NCHK * 128 * 4);
constexpr size_t WS_H = WS_MIN + al256((size_t)NCHAIN * NCHK * 4);
constexpr size_t WS_HG = WS_H + al256((size_t)MAXSLOT * EXPD * 2);
constexpr size_t WS_YS = WS_HG + al256((size_t)MAXSLOT * DM * 2);
constexpr size_t WS_ROUTE = WS_YS + al256((size_t)MAXSLOT * DM * 2);
constexpr size_t WS_HIST = WS_ROUTE + al256((size_t)MROWS * 16);
constexpr size_t WS_SLOT = WS_HIST + al256((size_t)256 * 8 * 4);
constexpr size_t WS_HT = WS_SLOT + al256((size_t)MROWS * 2 * 4);
constexpr size_t WS_FNORM = WS_HT + al256((size_t)512 * MROWS * 2);
constexpr size_t WS_YC = WS_FNORM + al256((size_t)2 * 4 * 2 * 512 * 4);
constexpr size_t WS_END = WS_YC + al256((size_t)11 * NCTX * DM * 2);
static_assert((size_t)MAXSLOT * EXPD >= (size_t)MROWS * FFN, "H buffer");

constexpr int LDS_BYTES = 163840, MISC_OFF = 159744;
constexpr int CW_BAR = 4096;

struct Args { const float* in[34]; float* out; unsigned char* ws; int ph_lo, ph_hi; };

DI float bf2f(unsigned v) { return __uint_as_float(v << 16); }
DI unsigned pk2(float lo, float hi) { return pg8::cvt_pk_bf16(lo, hi); }
DI bf16_t f2bf(float v) { return (bf16_t)(pk2(v, 0.f) & 0xffffu); }
DI float clamp8(float v) { return fminf(fmaxf(v, -448.0f), 448.0f); }
DI unsigned pk4_fp8(float a, float b, float c, float d) { int p = __builtin_amdgcn_cvt_pk_fp8_f32(clamp8(a), clamp8(b), 0, false); p = __builtin_amdgcn_cvt_pk_fp8_f32(clamp8(c), clamp8(d), p, true); return (unsigned)p; }
constexpr float W8_SCALE = 64.0f, H8_SCALE = 8.0f;
constexpr int SC_W8 = 0x79797979, SC_H8 = 0x7c7c7c7c, SC_ONE = 0x7f7f7f7f;
DI float wave_sum(float v) {
#pragma unroll
    for (int o = 1; o < 64; o <<= 1) v += mk_shx(v, o);
    return v;
}
DI int crow(int reg, int h) { return (reg & 3) + 8 * (reg >> 2) + 4 * h; }
DI float logsigmoid(float x) { return fminf(x, 0.f) - log1pf(expf(-fabsf(x))); }
#define MFMA32(a, b, c) __builtin_amdgcn_mfma_f32_32x32x16_bf16((a), (b), (c), 0, 0, 0)
DI f32x16 zero16() { f32x16 z;
#pragma unroll
    for (int i = 0; i < 16; ++i) z[i] = 0.f; return z; }
DI bf16x8 pack8(const f32x16& x, int s) {
    u32x4 p; p.x = pk2(x[8 * s + 0], x[8 * s + 1]); p.y = pk2(x[8 * s + 2], x[8 * s + 3]); p.z = pk2(x[8 * s + 4], x[8 * s + 5]); p.w = pk2(x[8 * s + 6], x[8 * s + 7]);
    return __builtin_bit_cast(bf16x8, p);
}
DI bf16x8 ld2x8(const bf16_t* p0, const bf16_t* p1) {
    unsigned a0 = (unsigned)(size_t)(const LAS bf16_t*)p0, a1 = (unsigned)(size_t)(const LAS bf16_t*)p1;
    asm volatile("" : "+v"(a1));
    const u32x2 a = *(const LAS u32x2*)(size_t)a0, b = *(const LAS u32x2*)(size_t)a1; u32x4 p; p.x = a.x; p.y = a.y; p.z = b.x; p.w = b.y; return __builtin_bit_cast(bf16x8, p);
}

#define XB_TMO      128
#define XB_XCNT(j)  (256  + 64 * (j))
#define XB_XSUB(j)  (1280 + 64 * (j))
#define XB_XGEN(j)  (2304 + 64 * (j))
#define XB_TOP      3328
#define XB_TOPGEN   3392
#define XCD_BAR_WORDS 3456
#define XB_SPIN_CAP (1u << 18)
DI unsigned xb_ld(unsigned* p)              { return __hip_atomic_load(p, __ATOMIC_RELAXED, __HIP_MEMORY_SCOPE_AGENT); }
DI unsigned xb_add(unsigned* p, unsigned v) { return __hip_atomic_fetch_add(p, v, __ATOMIC_RELAXED, __HIP_MEMORY_SCOPE_AGENT); }
DI unsigned xb_xcc_id() { return (unsigned)__builtin_amdgcn_s_getreg((3 << 11) | 20) & 0xFu; }
#define XB_SPIN(cond, bar) do { unsigned _sp = 0; while (cond) { __builtin_amdgcn_s_sleep(1); \
    if ((++_sp & 255u) == 0u) { if (xb_ld(&(bar)[XB_TMO])) break; if (_sp > XB_SPIN_CAP) { atomicAdd(&(bar)[XB_TMO], 1u); break; } } } } while (0)
struct XcdBarrier { unsigned* bar; unsigned x; volatile LAS unsigned* st; };
DI XcdBarrier xcd_barrier_post(unsigned* bar, volatile LAS unsigned* st) {
    XcdBarrier b; b.bar = bar; b.x = xb_xcc_id(); b.st = st;
    if (threadIdx.x == 0) (void)xb_add(&bar[XB_XCNT(b.x)], 1u);
    return b;
}
DI void xcd_barrier_complete(unsigned* bar, unsigned x, unsigned& nloc, unsigned& nx) {
    const unsigned G = gridDim.x * gridDim.y * gridDim.z;
    unsigned sum, cnt, mine, sp = 0u;
    for (;;) {
        sum = 0u; cnt = 0u; mine = 0u;
#pragma unroll
        for (unsigned j = 0; j < 16; ++j) { const unsigned c = xb_ld(&bar[XB_XCNT(j)]); sum += c; cnt += (c > 0u) ? 1u : 0u; mine = (j == x) ? c : mine; }
        if (sum == G) break;
        __builtin_amdgcn_s_sleep(1);
        if ((++sp & 255u) == 0u) { if (xb_ld(&bar[XB_TMO])) break; if (sp > XB_SPIN_CAP) { atomicAdd(&bar[XB_TMO], 1u); break; } }
    }
    nloc = mine > 0u ? mine : 1u; nx = cnt > 0u ? cnt : 1u;
}
DI void xcd_barrier(const XcdBarrier& b) {
    asm volatile("s_waitcnt vmcnt(0)" ::: "memory");
    __syncthreads();
    if (threadIdx.x == 0) {
        unsigned* bar = b.bar;
        __builtin_amdgcn_s_waitcnt(0);
        unsigned nloc = b.st[0], nx = b.st[1];
        if (nloc == 0u) { xcd_barrier_complete(bar, b.x, nloc, nx); b.st[0] = nloc; b.st[1] = nx; }
        const unsigned old = xb_add(&bar[XB_XSUB(b.x)], 1u);
        const unsigned gen = old / nloc;
        if (old + 1u == (gen + 1u) * nloc) {
            __builtin_amdgcn_fence(__ATOMIC_RELEASE, "agent");
            asm volatile("s_waitcnt vmcnt(0)" ::: "memory");
            const unsigned og = xb_add(&bar[XB_TOP], 1u);
            const unsigned tg = og / nx;
            if (og + 1u == (tg + 1u) * nx) xb_add(&bar[XB_TOPGEN], 1u);
            else XB_SPIN(xb_ld(&bar[XB_TOPGEN]) == tg, bar);
            __builtin_amdgcn_fence(__ATOMIC_ACQUIRE, "agent");
            xb_add(&bar[XB_XGEN(b.x)], 1u);
            asm volatile("s_waitcnt vmcnt(0)" ::: "memory");
        } else {
            XB_SPIN(xb_ld(&bar[XB_XGEN(b.x)]) == gen, bar);
            __builtin_amdgcn_fence(__ATOMIC_ACQUIRE, "agent");
            asm volatile("s_waitcnt vmcnt(0)" ::: "memory");
        }
    }
    __syncthreads();
}

DI void pro_mod_stage(const Args& a, unsigned char* lds) {
    const int tid = mk_otid();
    float* sv = (float*)lds;
    const float* c = a.in[1]; const float* cc = a.in[3];
    for (int i = tid; i < 3 * 2048; i += 512) { const int v = i >> 11, k = i & 2047; const float x = (v < 2) ? c[v * 2048 + k] : cc[k]; sv[i] = x / (1.0f + expf(-x)); }
    __syncthreads();
}
DI void pro_mod_units3(const Args& a, unsigned char* lds) {
    const int tid = mk_otid(), lane = tid & 63, wave = tid >> 6;
    const float* sv = (const float*)lds;
    float* red = (float*)(lds + 24576);
    const int bx = (int)blockIdx.x, pair = bx >> 3, layer = pair >> 3, strip = pair & 7, kc = bx & 7, k0 = kc * 256 + wave * 32;
    const float* W = a.in[4] + (size_t)layer * 2048 * 12288 + strip * 1536 + lane * 4 + (size_t)k0 * 12288;
    f32x4 acc[18];
#pragma unroll
    for (int i = 0; i < 18; ++i) acc[i] = (f32x4){0.f, 0.f, 0.f, 0.f};
#pragma unroll 4
    for (int k = 0; k < 32; ++k) { const float s0 = sv[k0 + k], s1 = sv[2048 + k0 + k], s2 = sv[4096 + k0 + k];
#pragma unroll
        for (int j = 0; j < 6; ++j) { const f32x4 w = __builtin_nontemporal_load((const f32x4*)(W + (size_t)k * 12288 + 256 * j));
            acc[3 * j] += w * s0; acc[3 * j + 1] += w * s1; acc[3 * j + 2] += w * s2; } }
    float* MODP = (float*)(a.ws + WS_P) + (size_t)kc * (4 * 3 * 12288);
#pragma unroll
    for (int half = 0; half < 2; ++half) {
#pragma unroll
        for (int i = 0; i < 9; ++i) *(f32x4*)(red + (wave * 9 + i) * 256 + lane * 4) = acc[9 * half + i];
        __syncthreads();
        for (int i = tid; i < 9 * 256; i += 512) { const int jv = i >> 8, j = 3 * half + jv / 3, v = jv % 3, col = i & 255;
            float s = kc == 0 ? a.in[5][layer * 12288 + strip * 1536 + 256 * j + col] : 0.f;
#pragma unroll
            for (int w = 0; w < 8; ++w) s += red[(w * 9 + jv) * 256 + col];
            MODP[(size_t)(layer * 3 + v) * 12288 + strip * 1536 + 256 * j + col] = s; }
        __syncthreads();
    }
}
DI void pro_mod_reduce(const Args& a) {
    const float* MODP = (const float*)(a.ws + WS_P); float* MOD = (float*)(a.ws + WS_MOD);
    for (int i = blockIdx.x * 512 + mk_otid(); i < 4 * 3 * 12288; i += gridDim.x * 512) { float s = MODP[i];
#pragma unroll
        for (int q = 1; q < 8; ++q) s += MODP[i + q * 147456];
        MOD[i] = s; }
}
DI int conv_dst_row(int mode, int n) {
    if (mode == 1) return (n >> 7) * 256 + (n & 127);
    if (mode == 2) return (n >> 7) * 256 + 128 + (n & 127);
    if (mode == 3) { const int hh = n >> 7, x = n & 127; return x < 64 ? hh * 64 + x : 512 + hh * 64 + (x - 64); }
    return n;
}
DI void conv_item(const float* W, int K, int N, int Nvalid, bf16_t* WT, int mode, int kb, int nb, float* scr  , int lane, float scale = 1.0f, int nsc = 0, bool f8 = false) {
    const int k0 = 64 * kb, n0 = 64 * nb, q = lane & 15, n = n0 + 4 * q;
    f32x4 v[16];
#pragma unroll
    for (int it = 0; it < 16; ++it) { const int kk = 4 * it + (lane >> 4); v[it] = (n < Nvalid) ? __builtin_nontemporal_load((const f32x4*)(W + (size_t)(k0 + kk) * N + n)) : (f32x4){0.f, 0.f, 0.f, 0.f}; }
#pragma unroll
    for (int it = 0; it < 16; ++it) { const int kk = 4 * it + (lane >> 4); float* d = scr + kk * 65 + 4 * q; d[0] = v[it][0]; d[1] = v[it][1]; d[2] = v[it][2]; d[3] = v[it][3]; }
    __builtin_amdgcn_s_waitcnt(0xc07f); __builtin_amdgcn_wave_barrier();
    const int c = lane & 7;
#pragma unroll
    for (int j = 0; j < 8; ++j) { const int nl = (lane >> 3) + 8 * j; const float* s = scr + (8 * c) * 65 + nl;
        const float sc = (n0 + nl) < nsc ? scale : 1.0f;
        if (f8) { u32x2 o8; o8.x = pk4_fp8(s[0 * 65] * sc, s[1 * 65] * sc, s[2 * 65] * sc, s[3 * 65] * sc); o8.y = pk4_fp8(s[4 * 65] * sc, s[5 * 65] * sc, s[6 * 65] * sc, s[7 * 65] * sc);
            *(u32x2*)((unsigned char*)WT + (size_t)conv_dst_row(mode, n0 + nl) * K + k0 + 8 * c) = o8; }
        else { u32x4 o; o.x = pk2(s[0 * 65] * sc, s[1 * 65] * sc); o.y = pk2(s[2 * 65] * sc, s[3 * 65] * sc); o.z = pk2(s[4 * 65] * sc, s[5 * 65] * sc); o.w = pk2(s[6 * 65] * sc, s[7 * 65] * sc);
            *(u32x4*)(WT + (size_t)conv_dst_row(mode, n0 + nl) * K + k0 + 8 * c) = o; } }
    __builtin_amdgcn_s_waitcnt(0xc07f); __builtin_amdgcn_wave_barrier();
}

DI void pro_convert(const Args& a, unsigned char* lds, int quarter) {
    const int tid = mk_otid(), lane = tid & 63, wave = __builtin_amdgcn_readfirstlane(tid >> 6);
    const int G = gridDim.x, gw = blockIdx.x * 8 + wave, NGW = G * 8;
    unsigned char* ws = a.ws;
        float* scr = (float*)(lds + wave * 16640);
        constexpr int I_IN = 32 * 84, I_OUT = 32 * 32, I_FG = 32 * 88, I_FD = 88 * 32, I_MG = 32 * 44, I_MD = 44 * 32, I_UQ = 8 * 12, I_UKV = 4 * 16;
        constexpr int T0 = 4 * I_IN, T1 = T0 + 4 * I_OUT, T2 = T1 + 2 * I_FG, T3 = T2 + 2 * I_FG, T4 = T3 + 2 * I_FD, T5 = T4 + 16 * I_MG, T6 = T5 + 16 * I_MG, T7 = T6 + 16 * I_MD, T8 = T7 + 4 * I_UQ, T9 = T8 + 4 * I_UKV;
        const int per = (T9 + 3) / 4, it_lo = quarter * per, it_hi = (it_lo + per < T9) ? it_lo + per : T9;
        for (int it = it_lo + gw; it < it_hi; it += NGW) {
            if (it < T0) { const int j = it / I_IN, r = it % I_IN; conv_item(a.in[10] + (size_t)j * DM * INW, DM, INW, INW, (bf16_t*)(ws + WS_WIN) + (size_t)j * INP * DM, 0, r / 84, r % 84, scr, lane, 0.125f * LOG2E, 512); }
            else if (it < T1) { const int q = it - T0, j = q / I_OUT, r = q % I_OUT; conv_item(a.in[11] + (size_t)j * DM * DM, DM, DM, DM, (bf16_t*)(ws + WS_WOUT) + (size_t)j * DM * DM, 0, r / 32, r % 32, scr, lane); }
            else if (it < T2) { const int q = it - T1, j = q / I_FG, r = q % I_FG; conv_item(a.in[27] + (size_t)j * DM * FFN, DM, FFN, FFN, (bf16_t*)(ws + WS_WGU + (size_t)j * 2 * FFN * DM), 1, 2 * ((r >> 1) / 88) + (r & 1), (r >> 1) % 88, scr, lane, W8_SCALE, 1 << 30, true); }
            else if (it < T3) { const int q = it - T2, j = q / I_FG, r = q % I_FG; conv_item(a.in[28] + (size_t)j * DM * FFN, DM, FFN, FFN, (bf16_t*)(ws + WS_WGU + (size_t)j * 2 * FFN * DM), 2, 2 * ((r >> 1) / 88) + (r & 1), (r >> 1) % 88, scr, lane, W8_SCALE, 1 << 30, true); }
            else if (it < T4) { const int q = it - T3, j = q / I_FD, r = q % I_FD; conv_item(a.in[29] + (size_t)j * FFN * DM, FFN, DM, DM, (bf16_t*)(ws + WS_WDN + (size_t)j * DM * FFN), 0, 2 * ((r >> 1) / 32) + (r & 1), (r >> 1) % 32, scr, lane, W8_SCALE, 1 << 30, true); }
            else if (it < T5) { const int q = it - T4, j = q / I_MG, r = q % I_MG; conv_item(a.in[31] + (size_t)j * DM * EXPD, DM, EXPD, EXPD, (bf16_t*)(ws + WS_WGUE + (size_t)j * 2 * EXPD * DM), 1, 2 * ((r >> 1) / 44) + (r & 1), (r >> 1) % 44, scr, lane, W8_SCALE, 1 << 30, true); }
            else if (it < T6) { const int q = it - T5, j = q / I_MG, r = q % I_MG; conv_item(a.in[32] + (size_t)j * DM * EXPD, DM, EXPD, EXPD, (bf16_t*)(ws + WS_WGUE + (size_t)j * 2 * EXPD * DM), 2, 2 * ((r >> 1) / 44) + (r & 1), (r >> 1) % 44, scr, lane, W8_SCALE, 1 << 30, true); }
            else if (it < T7) { const int q = it - T6, j = q / I_MD, r = q % I_MD; conv_item(a.in[33] + (size_t)j * EXPD * DM, EXPD, DM, DM, (bf16_t*)(ws + WS_WDNE + (size_t)j * DM * EXPD), 0, 2 * ((r >> 1) / 32) + (r & 1), (r >> 1) % 32, scr, lane, W8_SCALE, 1 << 30, true); }
            else if (it < T8) { const int q = it - T7, j = q / I_UQ, r = q % I_UQ; conv_item(a.in[24] + (size_t)j * 512 * 768, 512, 768, 768, (bf16_t*)(ws + WS_WUQ) + (size_t)j * 768 * 512, 0, r / 12, r % 12, scr, lane, 0.10206207261596577f * LOG2E, 768); }
            else { const int q = it - T8, j = q / I_UKV, r = q % I_UKV; conv_item(a.in[26] + (size_t)j * 256 * 1024, 256, 1024, 1024, (bf16_t*)(ws + WS_WUKV) + (size_t)j * 1024 * 256, 3, r / 16, r % 16, scr, lane); }
        }
}

DI void phase_pro_a(const Args& a, unsigned char* lds) {
    const int tid = mk_otid(), lane = tid & 63, wave = __builtin_amdgcn_readfirstlane(tid >> 6);
    const int G = gridDim.x, gw = blockIdx.x * 8 + wave, NGW = G * 8;
    unsigned char* ws = a.ws;
    pro_mod_stage(a, lds);
    pro_mod_units3(a, lds);
    {
        float* HDN = (float*)(ws + WS_HDN);
        const int layer = gw & 3;
        const float* w1 = a.in[14] + layer * 17 * 64; const float* w2 = a.in[16] + layer * 64 * 64; const float fr = a.in[18][layer * 64 + lane] * 0.15915494309189535f;
        const float b1 = a.in[15][layer * 64 + lane], b2 = a.in[17][layer * 64 + lane];
        float w1r[17], w2r[64];
#pragma unroll
        for (int k = 0; k < 17; ++k) w1r[k] = w1[k * 64 + lane];
#pragma unroll
        for (int k = 0; k < 64; ++k) w2r[k] = w2[k * 64 + lane];
        for (int it = gw; it < 4 * 4352; it += NGW) {
            const int p = it >> 2;
            const float tt = (p < 4096) ? (float)p / 4096.0f : (float)(p - 4096) / 256.0f;
            float pre = b1 + tt * w1r[0];
#pragma unroll
            for (int k = 1; k <= 8; ++k) { const float rev = tt * (float)k; pre += __builtin_amdgcn_sinf(rev) * w1r[k] + __builtin_amdgcn_cosf(rev) * w1r[8 + k]; }
            const float h1 = __builtin_amdgcn_sinf(__builtin_amdgcn_fractf(fr * pre));
            float pre2 = b2;
#pragma unroll
            for (int k = 0; k < 64; ++k) pre2 += __int_as_float(__builtin_amdgcn_readlane(__float_as_int(h1), k)) * w2r[k];
            HDN[((size_t)layer * 4352 + p) * 64 + lane] = __builtin_amdgcn_sinf(__builtin_amdgcn_fractf(fr * pre2));
        }
    }
    {
        f32x2* RA = (f32x2*)(ws + WS_ROPA); f32x2* RM = (f32x2*)(ws + WS_ROPM);
        const int gt = blockIdx.x * 512 + tid, NGT = G * 512;
        for (int i = gt; i < 4096 * 32; i += NGT) { const int pos = i >> 5, e = i & 31, part = e >> 4, k = e & 15; const float inv = powf(10000.0f, -(float)(2 * k) / 32.0f);
            const float ang = (float)(part ? (pos & 63) : (pos >> 6)) * inv; RA[i] = (f32x2){cosf(ang), sinf(ang)}; }
        for (int i = gt; i < 4096 * 16; i += NGT) { const int pos = i >> 4, e = i & 15, part = e >> 3, k = e & 7; const float inv = powf(10000.0f, -(float)(2 * k) / 16.0f);
            const float ang = (float)(part ? (pos & 63) : (pos >> 6)) * inv; RM[i] = (f32x2){cosf(ang), sinf(ang)}; }
    }
}

DI bf16x8 cvt8(const f32x4 a, const f32x4 b) { u32x4 p; p.x = pk2(a[0], a[1]); p.y = pk2(a[2], a[3]); p.z = pk2(b[0], b[1]); p.w = pk2(b[2], b[3]); return __builtin_bit_cast(bf16x8, p); }
template <int LL  >
DI void filt_tiles(const float* HDN  , const bf16x8 (&wf)[4], int c0, bf16_t* F16, float* F32, float (&s)[16], int wave, int r, int h) {
    constexpr int NT = LL / 32;
    f32x4 pa[8];
    if (wave < NT) { const float* hr = HDN + (size_t)(32 * wave + r) * 64 + 8 * h;
#pragma unroll
        for (int st = 0; st < 4; ++st) { pa[2 * st] = *(const f32x4*)(hr + 16 * st); pa[2 * st + 1] = *(const f32x4*)(hr + 16 * st + 4); } }
#pragma unroll 1
    for (int tile = wave; tile < NT; tile += 8) {
        const int t = 32 * tile + r;
        bf16x8 hf[4];
#pragma unroll
        for (int st = 0; st < 4; ++st) hf[st] = cvt8(pa[2 * st], pa[2 * st + 1]);
        if (tile + 8 < NT) { const float* hr = HDN + (size_t)(32 * (tile + 8) + r) * 64 + 8 * h;
#pragma unroll
            for (int st = 0; st < 4; ++st) { pa[2 * st] = *(const f32x4*)(hr + 16 * st); pa[2 * st + 1] = *(const f32x4*)(hr + 16 * st + 4); } }
        f32x16 acc = zero16();
#pragma unroll
        for (int st = 0; st < 4; ++st) acc = MFMA32(wf[st], hf[st], acc);
        const float tf = (float)t / (float)LL;
#pragma unroll
        for (int reg = 0; reg < 16; ++reg) { const int o = reg >> 3, dir = (reg >> 2) & 1, cc = (reg & 3) + 4 * h;
            const float delta = 3.0701134573253945f + (15.350567286626973f - 3.0701134573253945f) * (float)(c0 + cc) / 511.0f;
            float g = acc[reg] * expf(-tf * delta);
            if (dir == 0 || t > 0) s[reg] += fabsf(g);
            int m = dir == 0 ? LL - t : LL + t; if (dir == 1 && t == 0) { m = 0; g = 0.f; }
            if (LL == 4096) F16[((size_t)o * 512 + c0 + cc) * (2 * LL) + m] = f2bf(g); else F32[((size_t)o * 512 + c0 + cc) * (2 * LL) + m] = g; }
    }
}
DI void phase_pro_b(const Args& a, unsigned char* lds) {
    const int tid = mk_otid(), lane = tid & 63, wave = __builtin_amdgcn_readfirstlane(tid >> 6), r = lane & 31, h = lane >> 5;
    pro_mod_reduce(a);
    float* red = (float*)lds;
    const int fq = blockIdx.x & 3;
#pragma unroll 1
    for (int quarter = 0; quarter < 4; ++quarter) {
    pro_convert(a, lds, quarter);
    if (quarter != fq) continue;
    __syncthreads();
    for (int u = blockIdx.x; u < 256; u += gridDim.x) {
        const int layer = u >> 6, cg = u & 63, c0 = cg * 8;
        const float* w3 = a.in[19] + (size_t)layer * 64 * 2048;
        bf16x8 wf[4];
        { const int q = r, col = ((q >> 4) * 2 + ((q >> 3) & 1)) * 512 + c0 + (q & 7);
#pragma unroll
          for (int st = 0; st < 4; ++st) { float v[8];
#pragma unroll
              for (int j = 0; j < 8; ++j) v[j] = w3[(size_t)(16 * st + 8 * h + j) * 2048 + col];
              wf[st] = cvt8((f32x4){v[0], v[1], v[2], v[3]}, (f32x4){v[4], v[5], v[6], v[7]}); } }
#pragma unroll 1
        for (int which = 0; which < 2; ++which) {
            const float* HDN = (const float*)(a.ws + WS_HDN) + ((size_t)layer * 4352 + (which ? 4096 : 0)) * 64;
            float s[16];
#pragma unroll
            for (int i = 0; i < 16; ++i) s[i] = 0.f;
            if (which == 0) filt_tiles<4096>(HDN, wf, c0, (bf16_t*)(a.ws + WS_FILT) + (size_t)layer * 2 * 512 * 8192, nullptr, s, wave, r, h);
            else filt_tiles<256>(HDN, wf, c0, nullptr, (float*)(a.ws + WS_FILTC) + (size_t)layer * 2 * 512 * 512, s, wave, r, h);
#pragma unroll
            for (int reg = 0; reg < 16; ++reg) { float v = s[reg];
#pragma unroll
                for (int o2 = 1; o2 < 32; o2 <<= 1) v += mk_shx(v, o2);
                if (r == 0) red[wave * 32 + crow(reg, h)] = v; }
            __syncthreads();
            if (tid < 16) { const int o = tid >> 3, cc = tid & 7; float t = 0.f; for (int w = 0; w < 8; ++w) t += red[w * 32 + o * 16 + cc] + red[w * 32 + o * 16 + 8 + cc];
                ((float*)(a.ws + WS_FNORM))[((which * 4 + layer) * 2 + o) * 512 + c0 + cc] = t; }
            __syncthreads();
        }
    }
    __syncthreads();
    }
}

struct NormP {
    const float* xin_lat; const float* xin_ctx; float* xout_lat; float* xout_ctx; int nrows;
    int xin_b16, xout_b16;
    const bf16_t* ysrc; const int* slot; const f32x4* route;
    const float* mod_gate; const float* gpost;
    const float* mod_shift; const float* mod_scale; const float* gpre; bf16_t* ha;
    const float* router; f32x4* route_out; int* hist_out;
    int ha8;
    const bf16_t* yctx; int nsc;
};
struct NormRow { f32x4 x[8]; u32x2 xb[8]; u32x2 y0[8]; u32x2 y1[8]; f32x4 rt; };
template <bool RES, bool MOE, bool XB>
DI void norm_load(const NormP& p, int row, int lane, NormRow& R) {
    if (XB) { const bf16_t* xr = row < NLAT ? (const bf16_t*)p.xin_lat + (size_t)row * DM : (const bf16_t*)p.xin_ctx + (size_t)(row - NLAT) * DM;
#pragma unroll
        for (int j = 0; j < 8; ++j) R.xb[j] = *(const u32x2*)(xr + 256 * j + 4 * lane); }
    else { const float* xr = row < NLAT ? p.xin_lat + (size_t)row * DM : p.xin_ctx + (size_t)(row - NLAT) * DM;
#pragma unroll
        for (int j = 0; j < 8; ++j) R.x[j] = *(const f32x4*)(xr + 256 * j + 4 * lane); }
    if (RES) {
        if (MOE) { const int p0 = p.slot[row * 2], p1 = p.slot[row * 2 + 1]; R.rt = p.route[row];
            const bf16_t* y0 = p.ysrc + (size_t)p0 * DM, *y1 = p.ysrc + (size_t)p1 * DM;
#pragma unroll
            for (int j = 0; j < 8; ++j) { R.y0[j] = *(const u32x2*)(y0 + 256 * j + 4 * lane); R.y1[j] = *(const u32x2*)(y1 + 256 * j + 4 * lane); }
        } else if (!(p.yctx && row >= NLAT)) { const bf16_t* y0 = p.ysrc + (size_t)row * DM;
#pragma unroll
            for (int j = 0; j < 8; ++j) R.y0[j] = *(const u32x2*)(y0 + 256 * j + 4 * lane); }
    }
}
template <bool RES, bool MOE, bool HAOUT, bool ROUTER, bool XB = true>
DI void norm_phase(const NormP& p, unsigned char* lds) {
    const int tid = mk_otid(), lane = tid & 63, wave = tid >> 6;
    float* L = (float*)lds;
    float* Lgate = L, *Lshift = L + 6144, *Lscale = L + 12288, *Lgpost = L + 18432, *Lgpre = L + 20480, *Lrouter = L + 22528;
    int* hist = (int*)(lds + 155648);
    const int G = gridDim.x, nl = NLAT / G, nc = p.nrows > NLAT ? NCTX / G : 0, nr = nl + nc, bx = blockIdx.x;
#define NROW(i) ((i) < nl ? bx * nl + (i) : NLAT + bx * nc + ((i) - nl))
    NormRow R;
    if (wave < nr) norm_load<RES, MOE, XB>(p, NROW(wave), lane, R);
    for (int i = tid; i < 3 * 512; i += 512) { const int v = i >> 9, d = 4 * (i & 511);
        if (RES) *(f32x4*)(Lgate + v * 2048 + d) = *(const f32x4*)(p.mod_gate + v * 12288 + d);
        if (HAOUT) { *(f32x4*)(Lshift + v * 2048 + d) = *(const f32x4*)(p.mod_shift + v * 12288 + d); *(f32x4*)(Lscale + v * 2048 + d) = *(const f32x4*)(p.mod_scale + v * 12288 + d); } }
    { const int d = 4 * tid; if (RES) *(f32x4*)(Lgpost + d) = *(const f32x4*)(p.gpost + d); if (HAOUT) *(f32x4*)(Lgpre + d) = *(const f32x4*)(p.gpre + d); }
    if (ROUTER) { for (int k = tid; k < 2048; k += 512) { const f32x4 ra = *(const f32x4*)(p.router + 8 * k), rb = *(const f32x4*)(p.router + 8 * k + 4);
            Lrouter[k] = ra[0]; Lrouter[2048 + k] = ra[1]; Lrouter[4096 + k] = ra[2]; Lrouter[6144 + k] = ra[3]; Lrouter[8192 + k] = rb[0]; Lrouter[10240 + k] = rb[1]; Lrouter[12288 + k] = rb[2]; Lrouter[14336 + k] = rb[3]; }
        if (tid < 8) hist[tid] = 0; }
    __syncthreads();
#pragma unroll 1
    for (int ri = wave; ri < nr; ri += 8) { const int row = NROW(ri);
        const int v = row < NLAT ? (row >> 12) : 2;
        f32x4 x[8], y[8];
#pragma unroll
        for (int j = 0; j < 8; ++j) { if (XB) { const u32x2 a = R.xb[j]; x[j] = (f32x4){bf2f(a.x & 0xffffu), bf2f(a.x >> 16), bf2f(a.y & 0xffffu), bf2f(a.y >> 16)}; } else x[j] = R.x[j]; }
        if (RES) {
            if (MOE) {
#pragma unroll
                for (int j = 0; j < 8; ++j) { const u32x2 a = R.y0[j], b = R.y1[j]; const f32x4 rt = R.rt;
                    y[j][0] = rt[2] * bf2f(a.x & 0xffffu) + rt[3] * bf2f(b.x & 0xffffu); y[j][1] = rt[2] * bf2f(a.x >> 16) + rt[3] * bf2f(b.x >> 16);
                    y[j][2] = rt[2] * bf2f(a.y & 0xffffu) + rt[3] * bf2f(b.y & 0xffffu); y[j][3] = rt[2] * bf2f(a.y >> 16) + rt[3] * bf2f(b.y >> 16); }
            } else if (p.yctx && row >= NLAT) {
#pragma unroll
                for (int j = 0; j < 8; ++j) y[j] = (f32x4){0.f, 0.f, 0.f, 0.f};
#pragma unroll 1
                for (int s0 = 0; s0 < p.nsc; s0 += 4) { u32x2 tq[4][8];
#pragma unroll
                    for (int i = 0; i < 4; ++i) { const int s = s0 + i < p.nsc ? s0 + i : p.nsc - 1; const bf16_t* ys = p.yctx + ((size_t)s * NCTX + (row - NLAT)) * DM;
#pragma unroll
                        for (int j = 0; j < 8; ++j) tq[i][j] = *(const u32x2*)(ys + 256 * j + 4 * lane); }
#pragma unroll
                    for (int i = 0; i < 4; ++i) { const float wgt = s0 + i < p.nsc ? 1.0f : 0.0f;
#pragma unroll
                        for (int j = 0; j < 8; ++j) { const u32x2 a = tq[i][j];
                            y[j][0] += wgt * bf2f(a.x & 0xffffu); y[j][1] += wgt * bf2f(a.x >> 16); y[j][2] += wgt * bf2f(a.y & 0xffffu); y[j][3] += wgt * bf2f(a.y >> 16); } } }
            } else {
#pragma unroll
                for (int j = 0; j < 8; ++j) { const u32x2 a = R.y0[j];
                    y[j][0] = bf2f(a.x & 0xffffu); y[j][1] = bf2f(a.x >> 16); y[j][2] = bf2f(a.y & 0xffffu); y[j][3] = bf2f(a.y >> 16); }
            }
        }
        if (ri + 8 < nr) norm_load<RES, MOE, XB>(p, NROW(ri + 8), lane, R);
        if (RES) {
            float ss = 0.f;
#pragma unroll
            for (int j = 0; j < 8; ++j) ss += (y[j][0] * y[j][0] + y[j][1] * y[j][1]) + (y[j][2] * y[j][2] + y[j][3] * y[j][3]);
            const float r = rsqrtf(wave_sum(ss) * (1.0f / DM) + EPS);
            float* xo = p.xout_b16 ? (float*)(row < NLAT ? (bf16_t*)p.xout_lat + (size_t)row * DM : (bf16_t*)p.xout_ctx + (size_t)(row - NLAT) * DM) : (row < NLAT ? p.xout_lat + (size_t)row * DM : p.xout_ctx + (size_t)(row - NLAT) * DM);
#pragma unroll
            for (int j = 0; j < 8; ++j) { const f32x4 g = *(const f32x4*)(Lgate + v * 2048 + 256 * j + 4 * lane), gp = *(const f32x4*)(Lgpost + 256 * j + 4 * lane);
                x[j] += g * (y[j] * r * gp);
                if (p.xout_b16) { u32x2 w; w.x = pk2(x[j][0], x[j][1]); w.y = pk2(x[j][2], x[j][3]); *(u32x2*)((bf16_t*)xo + 256 * j + 4 * lane) = w; } else *(f32x4*)(xo + 256 * j + 4 * lane) = x[j]; }
        }
        if (HAOUT) {
            float ss = 0.f;
#pragma unroll
            for (int j = 0; j < 8; ++j) ss += (x[j][0] * x[j][0] + x[j][1] * x[j][1]) + (x[j][2] * x[j][2] + x[j][3] * x[j][3]);
            const float r = rsqrtf(wave_sum(ss) * (1.0f / DM) + EPS);
            float lg[8];
#pragma unroll
            for (int e = 0; e < 8; ++e) lg[e] = 0.f;
            bf16_t* ho = p.ha + (size_t)row * DM;
#pragma unroll
            for (int j = 0; j < 8; ++j) { const f32x4 gp = *(const f32x4*)(Lgpre + 256 * j + 4 * lane), sh = *(const f32x4*)(Lshift + v * 2048 + 256 * j + 4 * lane), sc = *(const f32x4*)(Lscale + v * 2048 + 256 * j + 4 * lane);
                const f32x4 h = (x[j] * r * gp) * (sc + 1.0f) + sh;
                if (p.ha8) *(unsigned*)((unsigned char*)p.ha + (size_t)row * DM + 256 * j + 4 * lane) = pk4_fp8(h[0] * H8_SCALE, h[1] * H8_SCALE, h[2] * H8_SCALE, h[3] * H8_SCALE);
                else { u32x2 w; w.x = pk2(h[0], h[1]); w.y = pk2(h[2], h[3]); *(u32x2*)(ho + 256 * j + 4 * lane) = w; }
                if (ROUTER) {
#pragma unroll
                    for (int e = 0; e < 8; ++e) { const f32x4 rr = *(const f32x4*)(Lrouter + e * 2048 + 256 * j + 4 * lane);
                        lg[e] += (h[0] * rr[0] + h[1] * rr[1]) + (h[2] * rr[2] + h[3] * rr[3]); } } }
            if (ROUTER) {
#pragma unroll
                for (int e = 0; e < 8; ++e) lg[e] = wave_sum(lg[e]);
                int i0 = 0; float v0 = lg[0];
#pragma unroll
                for (int e = 1; e < 8; ++e) if (lg[e] > v0) { v0 = lg[e]; i0 = e; }
                int i1 = -1; float v1 = -3.0e38f;
#pragma unroll
                for (int e = 0; e < 8; ++e) if (e != i0 && lg[e] > v1) { v1 = lg[e]; i1 = e; }
                const float w0 = 1.0f / (1.0f + expf(v1 - v0)), w1 = 1.0f - w0;
                if (lane == 0) { p.route_out[row] = (f32x4){__int_as_float(i0), __int_as_float(i1), w0, w1}; atomicAdd(&hist[i0], 1); atomicAdd(&hist[i1], 1); }
            }
        }
    }
    if (ROUTER) { __syncthreads(); if (tid < 8) p.hist_out[blockIdx.x * 8 + tid] = hist[tid]; }
    __syncthreads();
#undef NROW
}

DI void phase_gather(const Args& a, int nrows, unsigned char* lds) {
    const int tid = mk_otid(), lane = tid & 63, wave = tid >> 6, G = gridDim.x;
    int* base = (int*)lds; int* tot = base + 8; int* pos = base + 32;
    const int* HIST = (const int*)(a.ws + WS_HIST); const f32x4* ROUTE = (const f32x4*)(a.ws + WS_ROUTE); int* SLOT = (int*)(a.ws + WS_SLOT);
    if (tid < 16) base[tid] = 0;
    __syncthreads();
    { const int e = tid & 7; int b = 0, t = 0; for (int w = tid >> 3; w < G; w += 64) { const int hc = HIST[w * 8 + e]; if (w < (int)blockIdx.x) b += hc; t += hc; }
      __hip_atomic_fetch_add(&base[e], b, __ATOMIC_RELAXED, __HIP_MEMORY_SCOPE_WORKGROUP); __hip_atomic_fetch_add(&tot[e], t, __ATOMIC_RELAXED, __HIP_MEMORY_SCOPE_WORKGROUP); }
    __syncthreads();
    const int nl = NLAT / G, nc = nrows > NLAT ? NCTX / G : 0, nr = nl + nc, bx = blockIdx.x;
#define NROW(i) ((i) < nl ? bx * nl + (i) : NLAT + bx * nc + ((i) - nl))
    if (wave == 0) {
        int seg[8]; int s = 0;
#pragma unroll
        for (int e = 0; e < 8; ++e) { seg[e] = s + base[e]; s += (tot[e] + 255) & ~255; }
        for (int r0 = 0; r0 < nr; r0 += 64) { const int ri = r0 + lane; const bool act = ri < nr; const int row = NROW(act ? ri : 0);
            const f32x4 rt = ROUTE[row]; const int e0 = act ? __float_as_int(rt[0]) : -1, e1 = act ? __float_as_int(rt[1]) : -1;
            int p0 = 0, p1 = 0;
#pragma unroll
            for (int e = 0; e < 8; ++e) { const unsigned long long m0 = __ballot(e0 == e), m1 = __ballot(e1 == e);
                const int c0 = (int)__builtin_amdgcn_mbcnt_hi((unsigned)(m0 >> 32), __builtin_amdgcn_mbcnt_lo((unsigned)m0, 0u)) + (int)__builtin_amdgcn_mbcnt_hi((unsigned)(m1 >> 32), __builtin_amdgcn_mbcnt_lo((unsigned)m1, 0u));
                if (e0 == e) p0 = seg[e] + c0; if (e1 == e) p1 = seg[e] + c0;
                seg[e] += __popcll(m0) + __popcll(m1); }
            if (act) { pos[2 * ri] = p0; pos[2 * ri + 1] = p1; SLOT[row * 2] = p0; SLOT[row * 2 + 1] = p1; } }
    }
    __syncthreads();
    const bf16_t* HA = (const bf16_t*)(a.ws + WS_HA); bf16_t* HG = (bf16_t*)(a.ws + WS_HG);
    for (int q = wave; q < 2 * nr; q += 8) { const int row = NROW(q >> 1); const u32x4* src = (const u32x4*)((const unsigned char*)HA + (size_t)row * DM); u32x4* dst = (u32x4*)((unsigned char*)HG + (size_t)pos[q] * DM);
#pragma unroll
        for (int k = 0; k < 2; ++k) dst[lane + 64 * k] = src[lane + 64 * k]; }
    __syncthreads();
#undef NROW
}
DI void moe_tiles(const Args& a, unsigned char* lds, pg8::GroupedOrder& S) {
    const int tid = mk_otid(), G = gridDim.x; int* tot = (int*)(lds + MISC_OFF + 64);
    const int* HIST = (const int*)(a.ws + WS_HIST);
    if (tid < 8) tot[tid] = 0;
    __syncthreads();
    { const int e = tid & 7; int t = 0; for (int w = tid >> 3; w < G; w += 64) t += HIST[w * 8 + e]; __hip_atomic_fetch_add(&tot[e], t, __ATOMIC_RELAXED, __HIP_MEMORY_SCOPE_WORKGROUP); }
    __syncthreads();
    int s = 0, st[9];
#pragma unroll
    for (int e = 0; e < 8; ++e) { st[e] = s; s += (tot[e] + 255) >> 8; }
    st[8] = s;
    S.s1 = __builtin_amdgcn_readfirstlane(st[1]); S.s2 = __builtin_amdgcn_readfirstlane(st[2]); S.s3 = __builtin_amdgcn_readfirstlane(st[3]); S.s4 = __builtin_amdgcn_readfirstlane(st[4]);
    S.s5 = __builtin_amdgcn_readfirstlane(st[5]); S.s6 = __builtin_amdgcn_readfirstlane(st[6]); S.s7 = __builtin_amdgcn_readfirstlane(st[7]); S.nM = __builtin_amdgcn_readfirstlane(st[8]);
    __syncthreads();
}

DI void task_rope(const Args& a) {
    bf16_t* P = (bf16_t*)(a.ws + WS_P); const f32x2* RA = (const f32x2*)(a.ws + WS_ROPA); const f32x2* RM = (const f32x2*)(a.ws + WS_ROPM);
    const int gt = blockIdx.x * 512 + mk_otid(), NGT = gridDim.x * 512;
    for (int i0 = gt; i0 < NLAT * 40; i0 += 3 * NGT) {
        u32x4 x1v[3], x2v[3]; bf16_t* bp[3];
#pragma unroll
        for (int k3 = 0; k3 < 3; ++k3) { const int i = i0 + k3 * NGT, ic = i < NLAT * 40 ? i : gt; const int row = ic / 40, r = ic % 40, hs = r >> 2, part = (r >> 1) & 1, i8 = (r & 1) * 8;
            bp[k3] = P + (size_t)row * INP + (hs < 8 ? 64 * hs : OFF_AK + 64 * (hs - 8)) + part * 32 + i8; x1v[k3] = *(const u32x4*)bp[k3]; x2v[k3] = *(const u32x4*)(bp[k3] + 16); }
#pragma unroll
        for (int k3 = 0; k3 < 3; ++k3) { const int i = i0 + k3 * NGT; if (i >= NLAT * 40) break;
            const int row = i / 40, r = i % 40, part = (r >> 1) & 1, i8 = (r & 1) * 8, pos = row & 4095;
            bf16_t* b = bp[k3]; const u32x4 x1 = x1v[k3], x2 = x2v[k3]; u32x4 o1, o2;
#pragma unroll
            for (int w = 0; w < 4; ++w) {
                const f32x2 cs0 = RA[pos * 32 + part * 16 + i8 + 2 * w], cs1 = RA[pos * 32 + part * 16 + i8 + 2 * w + 1];
                const float a0 = bf2f(x1[w] & 0xffffu), a1 = bf2f(x1[w] >> 16), b0 = bf2f(x2[w] & 0xffffu), b1 = bf2f(x2[w] >> 16);
                o1[w] = pk2(a0 * cs0.x - b0 * cs0.y, a1 * cs1.x - b1 * cs1.y); o2[w] = pk2(b0 * cs0.x + a0 * cs0.y, b1 * cs1.x + a1 * cs1.y); }
            *(u32x4*)b = o1; *(u32x4*)(b + 16) = o2; }
    }
    for (int i = gt; i < NLAT * 2; i += NGT) {
        const int row = i >> 1, part = i & 1, pos = row & 4095;
        bf16_t* b = P + (size_t)row * INP + OFF_DKR + part * 16;
        const u32x4 x1 = *(const u32x4*)b, x2 = *(const u32x4*)(b + 8); u32x4 o1, o2;
#pragma unroll
        for (int w = 0; w < 4; ++w) {
            const f32x2 cs0 = RM[pos * 16 + part * 8 + 2 * w], cs1 = RM[pos * 16 + part * 8 + 2 * w + 1];
            const float a0 = bf2f(x1[w] & 0xffffu), a1 = bf2f(x1[w] >> 16), b0 = bf2f(x2[w] & 0xffffu), b1 = bf2f(x2[w] >> 16);
            o1[w] = pk2(a0 * cs0.x - b0 * cs0.y, a1 * cs1.x - b1 * cs1.y); o2[w] = pk2(b0 * cs0.x + a0 * cs0.y, b1 * cs1.x + a1 * cs1.y); }
        *(u32x4*)b = o1; *(u32x4*)(b + 8) = o2;
    }
}
DI void task_mla_norm(const Args& a, int layer) {
    const int lane = mk_otid() & 63, gw = blockIdx.x * 8 + (mk_otid() >> 6), NGW = gridDim.x * 8;
    const bf16_t* P = (const bf16_t*)(a.ws + WS_P); bf16_t* QN = (bf16_t*)(a.ws + WS_QN); bf16_t* KVN = (bf16_t*)(a.ws + WS_KVN);
    const float* qn = a.in[23] + layer * 512 + 8 * lane; const float* kn = a.in[25] + layer * 256 + 4 * lane;
    u32x4 qv[5]; u32x2 kv[5];
#pragma unroll
    for (int k5 = 0; k5 < 5; ++k5) { const int row = gw + k5 * NGW; if (row < MROWS) { qv[k5] = *(const u32x4*)(P + (size_t)row * INP + OFF_DQ + 8 * lane); kv[k5] = *(const u32x2*)(P + (size_t)row * INP + OFF_DKV + 4 * lane); } }
#pragma unroll
    for (int k5 = 0; k5 < 5; ++k5) { const int row = gw + k5 * NGW; if (row >= MROWS) break;
        const u32x4 q = qv[k5];
        float f[8]; float ss = 0.f;
#pragma unroll
        for (int w = 0; w < 4; ++w) { f[2 * w] = bf2f(q[w] & 0xffffu); f[2 * w + 1] = bf2f(q[w] >> 16); ss += f[2 * w] * f[2 * w] + f[2 * w + 1] * f[2 * w + 1]; }
        const float r = rsqrtf(wave_sum(ss) * (1.0f / 512.0f) + EPS);
        u32x4 o;
#pragma unroll
        for (int w = 0; w < 4; ++w) o[w] = pk2(f[2 * w] * r * qn[2 * w], f[2 * w + 1] * r * qn[2 * w + 1]);
        *(u32x4*)(QN + (size_t)row * 512 + 8 * lane) = o;
        const u32x2 k = kv[k5];
        const float g0 = bf2f(k.x & 0xffffu), g1 = bf2f(k.x >> 16), g2 = bf2f(k.y & 0xffffu), g3 = bf2f(k.y >> 16);
        const float r2 = rsqrtf(wave_sum(g0 * g0 + g1 * g1 + g2 * g2 + g3 * g3) * (1.0f / 256.0f) + EPS);
        u32x2 o2; o2.x = pk2(g0 * r2 * kn[0], g1 * r2 * kn[1]); o2.y = pk2(g2 * r2 * kn[2], g3 * r2 * kn[3]);
        *(u32x2*)(KVN + (size_t)row * 256 + 4 * lane) = o2;
    }
    if (NGW * 5 < MROWS) for (int row = gw + 5 * NGW; row < MROWS; row += NGW) {
        const u32x4 q = *(const u32x4*)(P + (size_t)row * INP + OFF_DQ + 8 * lane);
        float f[8]; float ss = 0.f;
#pragma unroll
        for (int w = 0; w < 4; ++w) { f[2 * w] = bf2f(q[w] & 0xffffu); f[2 * w + 1] = bf2f(q[w] >> 16); ss += f[2 * w] * f[2 * w] + f[2 * w + 1] * f[2 * w + 1]; }
        const float r = rsqrtf(wave_sum(ss) * (1.0f / 512.0f) + EPS);
        u32x4 o;
#pragma unroll
        for (int w = 0; w < 4; ++w) o[w] = pk2(f[2 * w] * r * qn[2 * w], f[2 * w + 1] * r * qn[2 * w + 1]);
        *(u32x4*)(QN + (size_t)row * 512 + 8 * lane) = o;
        const u32x2 k = *(const u32x2*)(P + (size_t)row * INP + OFF_DKV + 4 * lane);
        const float g0 = bf2f(k.x & 0xffffu), g1 = bf2f(k.x >> 16), g2 = bf2f(k.y & 0xffffu), g3 = bf2f(k.y >> 16);
        const float r2 = rsqrtf(wave_sum(g0 * g0 + g1 * g1 + g2 * g2 + g3 * g3) * (1.0f / 256.0f) + EPS);
        u32x2 o2; o2.x = pk2(g0 * r2 * kn[0], g1 * r2 * kn[1]); o2.y = pk2(g2 * r2 * kn[2], g3 * r2 * kn[3]);
        *(u32x2*)(KVN + (size_t)row * 256 + 4 * lane) = o2;
    }
}
DI void task_transpose(const bf16_t* src, int sp, bf16_t* dst, int dp, int nrt, int nct, unsigned char* lds) {
    const int lane = mk_otid() & 63, wave = mk_otid() >> 6, gw = blockIdx.x * 8 + wave, NGW = gridDim.x * 8;
    bf16_t* tile = (bf16_t*)(lds + wave * 9216);
    for (int tl = gw; tl < nrt * nct; tl += 2 * NGW) {
        const int tl2 = tl + NGW; const bool two = tl2 < nrt * nct;
        const int ct = tl % nct, rt = tl / nct, ct2 = two ? tl2 % nct : ct, rt2 = two ? tl2 / nct : rt;
        u32x4 va[8], vb[8];
#pragma unroll
        for (int it = 0; it < 8; ++it) { const int rr = 8 * it + (lane >> 3), ch = lane & 7;
            va[it] = *(const u32x4*)(src + (size_t)(64 * rt + rr) * sp + 64 * ct + 8 * ch); vb[it] = *(const u32x4*)(src + (size_t)(64 * rt2 + rr) * sp + 64 * ct2 + 8 * ch); }
#pragma unroll
        for (int pass = 0; pass < 2; ++pass) {
            if (pass == 1 && !two) break;
            const int cct = pass ? ct2 : ct, rrt = pass ? rt2 : rt;
#pragma unroll
            for (int it = 0; it < 8; ++it) { const int rr = 8 * it + (lane >> 3), ch = lane & 7; *(u32x4*)(tile + rr * 72 + 8 * (ch ^ it)) = pass ? vb[it] : va[it]; }
            __builtin_amdgcn_s_waitcnt(0xc07f); __builtin_amdgcn_wave_barrier();
#pragma unroll
            for (int it = 0; it < 8; ++it) { const int j = 8 * it + (lane >> 3), tc = lane & 7; const bf16_t* s = tile + (8 * tc) * 72 + 8 * (it ^ tc) + (lane >> 3);
                u32x4 o; o.x = (unsigned)s[0] | ((unsigned)s[72] << 16); o.y = (unsigned)s[144] | ((unsigned)s[216] << 16); o.z = (unsigned)s[288] | ((unsigned)s[360] << 16); o.w = (unsigned)s[432] | ((unsigned)s[504] << 16);
                *(u32x4*)(dst + (size_t)(64 * cct + j) * dp + 64 * rrt + 8 * tc) = o; }
            __builtin_amdgcn_s_waitcnt(0xc07f); __builtin_amdgcn_wave_barrier();
        }
    }
}
DI float wscan_add(float v, int lane) {
#pragma unroll
    for (int o = 1; o < 64; o <<= 1) { const float t = __shfl_up(v, o); if (lane >= o) v += t; }
    return v; }
DI float wscan_max_up(float v, int lane) {
#pragma unroll
    for (int o = 1; o < 64; o <<= 1) { const float t = __shfl_up(v, o); if (lane >= o) v = fmaxf(v, t); }
    return v; }
DI float wscan_max_down(float v, int lane) {
#pragma unroll
    for (int o = 1; o < 64; o <<= 1) { const float t = __shfl_down(v, o); if (lane + o < 64) v = fmaxf(v, t); }
    return v; }
DI float wave_max(float v) {
#pragma unroll
    for (int o = 1; o < 64; o <<= 1) v = fmaxf(v, mk_shx(v, o));
    return v; }
DI float fexp(float x) { return __builtin_amdgcn_exp2f(x * 1.4426950408889634f); }
DI float frcp(float x) { return __builtin_amdgcn_rcpf(x); }
DI void mlstm_step1_unit(const Args& a, int layer, int u, unsigned char* lds) {
    const int tid = mk_otid(), lane = tid & 63, wave = __builtin_amdgcn_readfirstlane(tid >> 6), r = lane & 31, h = lane >> 5;
    const int b = u / (4 * NCHK), head = (u / NCHK) & 3, sc = u % NCHK; const bool isctx = sc < 2; const int ci = isctx ? sc : sc - 2;
    const int row0 = isctx ? NLAT + 256 * b + 128 * ci : 4096 * b + 128 * ci;
    float* li = (float*)lds; float* lf = li + 256; float* wv = li + 512;
    bf16_t* KT = (bf16_t*)(lds + 4096); bf16_t* VT0 = (bf16_t*)(lds + 4096 + 34816); bf16_t* VT1 = (bf16_t*)(lds + 4096 + 2 * 34816);
    const bf16_t* P = (const bf16_t*)(a.ws + WS_P); const float* gb = a.in[21] + layer * 16;
    const int ck0 = ((b * 8 + head * 2) * NCHK) + sc, ck1 = ((b * 8 + head * 2 + 1) * NCHK) + (isctx ? 1 - ci : 35 - sc);
    u32x4 kr4[4], vr4[4];
#pragma unroll
    for (int it = 0; it < 4; ++it) { const int idx = tid + 512 * it, s = idx & 127, f0 = (idx >> 7) * 8;
        kr4[it] = *(const u32x4*)(P + (size_t)(row0 + s) * INP + OFF_MK + head * 128 + f0); vr4[it] = *(const u32x4*)(P + (size_t)(row0 + s) * INP + OFF_MV + head * 128 + f0); }
    if (tid < 256) { const int dir = tid >> 7, s = tid & 127; const bf16_t* g = P + (size_t)(row0 + s) * INP + OFF_MG;
        li[dir * 128 + s] = bf2f(g[(2 * dir) * 4 + head]) + gb[(2 * dir) * 4 + head]; lf[dir * 128 + s] = logsigmoid(bf2f(g[(2 * dir + 1) * 4 + head]) + gb[(2 * dir + 1) * 4 + head]); }
    __syncthreads();
    if (tid < 128) {
        const int dir = wave; const float* lfd = lf + dir * 128; const float* lid = li + dir * 128;
        const float f0 = lfd[2 * lane], f1 = lfd[2 * lane + 1];
        const float inc = wscan_add(f0 + f1, lane), total = __shfl(inc, 63);
        const float p0 = inc - f1, p1 = inc;
        const float lw0 = (dir == 0 ? total - p0 : p0 - f0) + lid[2 * lane], lw1 = (dir == 0 ? total - p1 : p1 - f1) + lid[2 * lane + 1];
        const float mx = wave_max(fmaxf(lw0, lw1));
        wv[dir * 128 + 2 * lane] = fexp(lw0 - mx); wv[dir * 128 + 2 * lane + 1] = fexp(lw1 - mx);
        if (lane == 0) { float* ML = (float*)(a.ws + WS_ML) + (size_t)(dir ? ck1 : ck0) * 2; ML[0] = total; ML[1] = mx; }
    }
    __syncthreads();
#pragma unroll
    for (int it = 0; it < 4; ++it) { const int idx = tid + 512 * it, s = idx & 127, f0 = (idx >> 7) * 8;
        const u32x4 kr = kr4[it], vr = vr4[it];
        const float w0 = wv[s], w1 = wv[128 + s];
#pragma unroll
        for (int e = 0; e < 4; ++e) { const float k0 = bf2f(kr[e] & 0xffffu) * 0.08838834764831845f, k1 = bf2f(kr[e] >> 16) * 0.08838834764831845f, v0 = bf2f(vr[e] & 0xffffu), v1 = bf2f(vr[e] >> 16);
            KT[(f0 + 2 * e) * 136 + s] = f2bf(k0); KT[(f0 + 2 * e + 1) * 136 + s] = f2bf(k1);
            VT0[(f0 + 2 * e) * 136 + s] = f2bf(v0 * w0); VT0[(f0 + 2 * e + 1) * 136 + s] = f2bf(v1 * w0);
            VT1[(f0 + 2 * e) * 136 + s] = f2bf(v0 * w1); VT1[(f0 + 2 * e + 1) * 136 + s] = f2bf(v1 * w1); } }
    __syncthreads();
#pragma unroll
    for (int q = 0; q < 4; ++q) { const int id = 4 * wave + q, dir = id >> 4, vt = (id >> 2) & 3, dt = id & 3; const bf16_t* VTd = dir ? VT1 : VT0;
        float* DC = (float*)(a.ws + WS_DC) + (size_t)(dir ? ck1 : ck0) * CSTATE;
        f32x16 acc = zero16();
#pragma unroll
        for (int st = 0; st < 8; ++st) { const bf16x8 A = *(const bf16x8*)(VTd + (32 * vt + r) * 136 + 16 * st + 8 * h), B = *(const bf16x8*)(KT + (32 * dt + r) * 136 + 16 * st + 8 * h); acc = MFMA32(A, B, acc); }
#pragma unroll
        for (int reg = 0; reg < 16; ++reg) DC[(32 * vt + crow(reg, h)) * 128 + 32 * dt + r] = acc[reg]; }
    {
        const int dir = tid >> 8, d = (tid >> 1) & 127, hf = tid & 1; float s0 = 0.f, s1 = 0.f;
        const unsigned* kt2 = (const unsigned*)(KT + d * 136 + 64 * hf); const float* wp = wv + dir * 128 + 64 * hf;
#pragma unroll 8
        for (int t = 0; t < 32; ++t) { const unsigned kk = kt2[t]; s0 += wp[2 * t] * bf2f(kk & 0xffffu); s1 += wp[2 * t + 1] * bf2f(kk >> 16); }
        float s = s0 + s1; s += mk_shx(s, 1);
        if (hf == 0) ((float*)(a.ws + WS_DC))[(size_t)(dir ? ck1 : ck0) * CSTATE + 16384 + d] = s; }
    __syncthreads();
}
DI void task_mlstm_scan(const Args& a) {
    const int gt = blockIdx.x * 512 + mk_otid(), NGT = gridDim.x * 512;
    const float* DC = (const float*)(a.ws + WS_DC); const float* ML = (const float*)(a.ws + WS_ML);
    bf16_t* CIN = (bf16_t*)(a.ws + WS_CIN); float* NIN = (float*)(a.ws + WS_NIN); float* MIN_ = (float*)(a.ws + WS_MIN);
    for (int e = gt; e < NCHAIN * CSTATE; e += NGT) {
        const int chain = e / CSTATE, el = e % CSTATE; float m = 0.f, cv = 0.f;
        const float* dcp = DC + (size_t)chain * NCHK * CSTATE + el; const float* mlp = ML + chain * NCHK * 2;
        float dq[17], tq[17], mq[17];
#pragma unroll 1
        for (int kb = 0; kb < NCHK; kb += 17) {
#pragma unroll
            for (int j = 0; j < 17; ++j) { dq[j] = dcp[(size_t)(kb + j) * CSTATE]; tq[j] = mlp[(kb + j) * 2]; mq[j] = mlp[(kb + j) * 2 + 1]; }
#pragma unroll
            for (int j = 0; j < 17; ++j) { const int ck = chain * NCHK + kb + j;
                if (el < 16384) CIN[(size_t)ck * 16384 + el] = f2bf(cv); else NIN[ck * 128 + el - 16384] = cv;
                if (el == 0) MIN_[ck] = m;
                const float mn = fmaxf(tq[j] + m, mq[j]);
                cv = fexp(tq[j] + m - mn) * cv + fexp(mq[j] - mn) * dq[j]; m = mn; }
        }
    }
}
DI void mlstm_step3_unit(const Args& a, int layer, int u, unsigned char* lds) {
    const int tid = mk_otid(), lane = tid & 63, wave = __builtin_amdgcn_readfirstlane(tid >> 6), r = lane & 31, h = lane >> 5;
    const int b = u / (4 * NCHK), head = (u / NCHK) & 3, sc = u % NCHK; const bool isctx = sc < 2; const int ci = isctx ? sc : sc - 2;
    const int row0 = isctx ? NLAT + 256 * b + 128 * ci : 4096 * b + 128 * ci;
    bf16_t* Qs = (bf16_t*)lds; bf16_t* Ks = (bf16_t*)(lds + 34816); bf16_t* VT = (bf16_t*)(lds + 69632);
    float* li = (float*)(lds + 104448); float* lf = li + 256; float* aarr = li + 512; float* Mt = li + 768; float* cumM = li + 1024; float* nvec = li + 1280; float* red = li + 1536;
    const bf16_t* P = (const bf16_t*)(a.ws + WS_P); const float* gb = a.in[21] + layer * 16;
    const int ck0 = ((b * 8 + head * 2) * NCHK) + sc, ck1 = ((b * 8 + head * 2 + 1) * NCHK) + (isctx ? 1 - ci : 35 - sc);
    const int tt = wave & 3, vh = wave >> 2, t = 32 * tt + r;
    const float m_in0 = ((const float*)(a.ws + WS_MIN))[ck0], m_in1 = ((const float*)(a.ws + WS_MIN))[ck1];
    if (tid < 256) { const int dir = tid >> 7, s = tid & 127; const bf16_t* g = P + (size_t)(row0 + s) * INP + OFF_MG;
        nvec[dir * 128 + s] = ((const float*)(a.ws + WS_NIN))[(dir ? ck1 : ck0) * 128 + s];
        li[dir * 128 + s] = bf2f(g[(2 * dir) * 4 + head]) + gb[(2 * dir) * 4 + head]; lf[dir * 128 + s] = logsigmoid(bf2f(g[(2 * dir + 1) * 4 + head]) + gb[(2 * dir + 1) * 4 + head]); }
    {
        u32x4 qr[4], kr[4], vr[4];
#pragma unroll
        for (int it = 0; it < 4; ++it) { const int idx = tid + 512 * it, s = idx & 127, f0 = (idx >> 7) * 8; const bf16_t* pr = P + (size_t)(row0 + s) * INP + head * 128 + f0;
            qr[it] = *(const u32x4*)(pr + OFF_MQ); kr[it] = *(const u32x4*)(pr + OFF_MK); vr[it] = *(const u32x4*)(pr + OFF_MV); }
#pragma unroll
        for (int it = 0; it < 4; ++it) { const int idx = tid + 512 * it, s = idx & 127, f0 = (idx >> 7) * 8; u32x4 ks;
#pragma unroll
            for (int e = 0; e < 4; ++e) { ks[e] = pk2(bf2f(kr[it][e] & 0xffffu) * 0.08838834764831845f, bf2f(kr[it][e] >> 16) * 0.08838834764831845f);
                VT[(f0 + 2 * e) * 136 + s] = (bf16_t)(vr[it][e] & 0xffffu); VT[(f0 + 2 * e + 1) * 136 + s] = (bf16_t)(vr[it][e] >> 16); }
            *(u32x4*)(Qs + s * 136 + f0) = qr[it]; *(u32x4*)(Ks + s * 136 + f0) = ks; } }
    bf16x8 cf[16];
    { const bf16_t* C0 = (const bf16_t*)(a.ws + WS_CIN) + (size_t)ck0 * 16384 + (size_t)(64 * vh + r) * 128 + 8 * h;
#pragma unroll
      for (int j = 0; j < 2; ++j)
#pragma unroll
          for (int st = 0; st < 8; ++st) cf[j * 8 + st] = *(const bf16x8*)(C0 + j * 32 * 128 + 16 * st); }
    __syncthreads();
    if (tid < 128) {
        const int dir = wave; const float m_in = dir ? m_in1 : m_in0; const float* lfd = lf + dir * 128; const float* lid = li + dir * 128;
        const float f0 = lfd[2 * lane], f1 = lfd[2 * lane + 1];
        const float inc = wscan_add(f0 + f1, lane), total = __shfl(inc, 63);
        const float p0 = inc - f1, p1 = inc;
        const float c0 = dir == 0 ? p0 : total - p0 + f0, c1 = dir == 0 ? p1 : total - p1 + f1;
        const float a0 = lid[2 * lane] - c0, a1 = lid[2 * lane + 1] - c1;
        float A0, A1;
        if (dir == 0) { const float scn = wscan_max_up(fmaxf(a0, a1), lane); const float prev = __shfl_up(scn, 1); A0 = lane > 0 ? fmaxf(prev, a0) : a0; A1 = scn; }
        else { const float scn = wscan_max_down(fmaxf(a0, a1), lane); const float nxt = __shfl_down(scn, 1); A1 = lane < 63 ? fmaxf(nxt, a1) : a1; A0 = scn; }
        const float M0 = fmaxf(m_in, A0), M1 = fmaxf(m_in, A1);
        aarr[dir * 128 + 2 * lane] = a0; aarr[dir * 128 + 2 * lane + 1] = a1; Mt[dir * 128 + 2 * lane] = M0; Mt[dir * 128 + 2 * lane + 1] = M1; cumM[dir * 128 + 2 * lane] = c0 + M0; cumM[dir * 128 + 2 * lane + 1] = c1 + M1;
    }
    __syncthreads();
    bf16x8 qf[8];
#pragma unroll
    for (int st = 0; st < 8; ++st) qf[st] = *(const bf16x8*)(Qs + t * 136 + 16 * st + 8 * h);
    f32x16 hs0 = zero16(), hs1 = zero16();
#pragma unroll 1
    for (int dir = 0; dir < 2; ++dir) {
        const float m_in = dir ? m_in1 : m_in0; const float* aar = aarr + dir * 128; const float* nv = nvec + dir * 128;
        const float Mq = Mt[dir * 128 + t], winter = fexp(m_in - Mq);
        f32x16 n0 = zero16(), n1 = zero16();
#pragma unroll
        for (int st = 0; st < 8; ++st) { n0 = MFMA32(cf[st], qf[st], n0); n1 = MFMA32(cf[8 + st], qf[st], n1); }
        if (dir == 0) {
            const bf16_t* C1 = (const bf16_t*)(a.ws + WS_CIN) + (size_t)ck1 * 16384 + (size_t)(64 * vh + r) * 128 + 8 * h;
#pragma unroll
            for (int j = 0; j < 2; ++j)
#pragma unroll
                for (int st = 0; st < 8; ++st) cf[j * 8 + st] = *(const bf16x8*)(C1 + j * 32 * 128 + 16 * st); }
        float nq = 0.f;
#pragma unroll
        for (int st = 0; st < 8; ++st)
#pragma unroll
            for (int j = 0; j < 8; ++j) nq += nv[16 * st + 8 * h + j] * bf2f((unsigned)(unsigned short)qf[st][j]);
        nq += mk_shx(nq, 32);
#pragma unroll
        for (int reg = 0; reg < 16; ++reg) { n0[reg] *= winter; n1[reg] *= winter; }
        float dsum = 0.f;
        const int si_lo = dir ? tt : 0, si_hi = dir ? 3 : tt;
#pragma unroll 1
        for (int si = si_lo; si <= si_hi; ++si) {
            f32x16 S = zero16();
#pragma unroll
            for (int st = 0; st < 8; ++st) { const bf16x8 A = *(const bf16x8*)(Ks + (32 * si + r) * 136 + 16 * st + 8 * h); S = MFMA32(A, qf[st], S); }
#pragma unroll
            for (int reg = 0; reg < 16; ++reg) { const int s = 32 * si + crow(reg, h); const bool ok = dir ? (s >= t) : (s <= t);
                const float ex = (si != tt || ok) ? (aar[s] - Mq) * 1.4426950408889634f : -1.0e30f; const float dv = __builtin_amdgcn_exp2f(ex); S[reg] *= dv; dsum += S[reg]; }
            const bf16x8 pb0 = pack8(S, 0), pb1 = pack8(S, 1);
            const bf16_t* v0 = VT + (64 * vh + r) * 136 + 32 * si + 4 * h; const bf16_t* v1 = v0 + 32 * 136;
            n0 = MFMA32(ld2x8(v0, v0 + 8), pb0, n0); n0 = MFMA32(ld2x8(v0 + 16, v0 + 24), pb1, n0);
            n1 = MFMA32(ld2x8(v1, v1 + 8), pb0, n1); n1 = MFMA32(ld2x8(v1 + 16, v1 + 24), pb1, n1);
        }
        dsum += mk_shx(dsum, 32);
        const float den = winter * nq + dsum, dn = fmaxf(fabsf(den), fexp(-cumM[dir * 128 + t])), inv = frcp(dn);
#pragma unroll
        for (int reg = 0; reg < 16; ++reg) { hs0[reg] += n0[reg] * inv; hs1[reg] += n1[reg] * inv; }
    }
    u32x2 ovp[8];
    { const bf16_t* og = P + (size_t)(row0 + t) * INP + OFF_MO + head * 128;
#pragma unroll
      for (int vt2 = 0; vt2 < 2; ++vt2)
#pragma unroll
          for (int g4 = 0; g4 < 4; ++g4) ovp[vt2 * 4 + g4] = *(const u32x2*)(og + 64 * vh + 32 * vt2 + 8 * g4 + 4 * h); }
    float ss = 0.f;
#pragma unroll
    for (int reg = 0; reg < 16; ++reg) ss += hs0[reg] * hs0[reg] + hs1[reg] * hs1[reg];
    ss += mk_shx(ss, 32);
    if (h == 0) red[vh * 128 + t] = ss;
    __syncthreads();
    const float rstd = rsqrtf((red[t] + red[128 + t]) * (1.0f / 128.0f) + EPS);
    const float* gn = a.in[22] + layer * 512 + head * 128; bf16_t* MIX = (bf16_t*)(a.ws + WS_MIX) + (size_t)(row0 + t) * DM + 1024 + head * 128;
#pragma unroll
    for (int vt2 = 0; vt2 < 2; ++vt2)
#pragma unroll
        for (int g4 = 0; g4 < 4; ++g4) { const int v0 = 64 * vh + 32 * vt2 + 8 * g4 + 4 * h; const u32x2 ov = ovp[vt2 * 4 + g4];
            float o[4] = {bf2f(ov.x & 0xffffu), bf2f(ov.x >> 16), bf2f(ov.y & 0xffffu), bf2f(ov.y >> 16)}; float y[4];
#pragma unroll
            for (int e = 0; e < 4; ++e) { const float hv = (vt2 ? hs1[4 * g4 + e] : hs0[4 * g4 + e]) * rstd * gn[v0 + e]; y[e] = hv * frcp(1.0f + fexp(-o[e])); }
            u32x2 w; w.x = pk2(y[0], y[1]); w.y = pk2(y[2], y[3]); *(u32x2*)(MIX + v0) = w; }
    __syncthreads();
}

DI float max3f(float a, float b, float c) { return fmaxf(a, fmaxf(b, c)); }
DI float xhalf_max(float v) { const auto rr = __builtin_amdgcn_permlane32_swap(__float_as_uint(v), __float_as_uint(v), false, false); return fmaxf(__uint_as_float(rr[0]), __uint_as_float(rr[1])); }
DI void attn_tile(f32x16& o0, f32x16& o1, float& m, float& l, f32x16 x, float sl2, bool mask, int qpos, int kpos0, int h, const bf16_t* vp, size_t dts) {
    float tmax = -3.0e38f;
#pragma unroll
    for (int reg = 0; reg < 16; ++reg) { if (mask) { const int dd = qpos - (kpos0 + crow(reg, h)); if (dd > 128 || dd < -128) x[reg] = -1.0e30f; } }
#pragma unroll
    for (int reg = 0; reg < 16; reg += 2) tmax = max3f(tmax, x[reg], x[reg + 1]);
    tmax = xhalf_max(tmax);
    if (__any(tmax > m)) {
        const float mn = fmaxf(m, tmax), alpha = __builtin_amdgcn_exp2f(m - mn); m = mn; l *= alpha;
#pragma unroll
        for (int reg = 0; reg < 16; ++reg) { o0[reg] *= alpha; o1[reg] *= alpha; }
    }
    float ps = 0.f;
#pragma unroll
    for (int reg = 0; reg < 16; ++reg) { const float p = __builtin_amdgcn_exp2f(x[reg] - m); x[reg] = p; ps += p; }
    l += ps;
    const bf16x8 pb0 = pack8(x, 0), pb1 = pack8(x, 1);
    o0 = MFMA32(ld2x8(vp, vp + 8), pb0, o0); o0 = MFMA32(ld2x8(vp + 16, vp + 24), pb1, o0);
    o1 = MFMA32(ld2x8(vp + dts, vp + dts + 8), pb0, o1); o1 = MFMA32(ld2x8(vp + dts + 16, vp + dts + 24), pb1, o1);
}
DI void attn_tile2(f32x16& o0, f32x16& o1, float& m, float& l, f32x16 x0, f32x16 x1, float sl2, int h, const bf16_t* vp  , int dts  ) {
    float tmax = -3.0e38f;
#pragma unroll
    for (int reg = 0; reg < 16; ++reg) tmax = max3f(tmax, x0[reg], x1[reg]);
    tmax = xhalf_max(tmax);
    if (__any(tmax > m)) {
        const float mn = fmaxf(m, tmax), alpha = __builtin_amdgcn_exp2f(m - mn); m = mn; l *= alpha;
#pragma unroll
        for (int reg = 0; reg < 16; ++reg) { o0[reg] *= alpha; o1[reg] *= alpha; }
    }
    float ps = 0.f;
#pragma unroll
    for (int reg = 0; reg < 16; ++reg) { const float p0 = __builtin_amdgcn_exp2f(x0[reg] - m), p1 = __builtin_amdgcn_exp2f(x1[reg] - m); x0[reg] = p0; x1[reg] = p1; ps += p0 + p1; }
    l += ps;
    const bf16x8 pa0 = pack8(x0, 0), pa1 = pack8(x0, 1), pb0 = pack8(x1, 0), pb1 = pack8(x1, 1);
    o0 = MFMA32(*(const bf16x8*)(vp), pa0, o0);            o1 = MFMA32(*(const bf16x8*)(vp + dts), pa0, o1);
    o0 = MFMA32(*(const bf16x8*)(vp + 16), pa1, o0);       o1 = MFMA32(*(const bf16x8*)(vp + dts + 16), pa1, o1);
    o0 = MFMA32(*(const bf16x8*)(vp + 32), pb0, o0);       o1 = MFMA32(*(const bf16x8*)(vp + dts + 32), pb0, o1);
    o0 = MFMA32(*(const bf16x8*)(vp + 48), pb1, o0);       o1 = MFMA32(*(const bf16x8*)(vp + dts + 48), pb1, o1);
}
DI int imax3(int a, int b, int c) { const int t = a > b ? a : b; return t > c ? t : c; }
DI float bf16_round(float x) { return bf2f(pk2(x, 0.f) & 0xffffu); }
DI void attn_tile4(f32x16& o0, f32x16& o1, f32x16& lacc, float& m, bf16x8& q6, f32x16 x0, f32x16 x1, int h, const bf16_t* vp  , int dts  , unsigned ones2  ) {
    int ti = (int)0x80000000;
#pragma unroll
    for (int reg = 0; reg < 16; ++reg) ti = imax3(ti, __float_as_int(x0[reg]), __float_as_int(x1[reg]));
    { const auto rr = __builtin_amdgcn_permlane32_swap((unsigned)ti, (unsigned)ti, false, false); const int a = (int)rr[0], b = (int)rr[1]; ti = a > b ? a : b; }
    const float tmax = __int_as_float(ti);
    if (__any(tmax > 8.0f)) {
        const float mn = tmax > 8.0f ? bf16_round(m + tmax) : m, d = mn - m, alpha = __builtin_amdgcn_exp2f(-d); m = mn;
#pragma unroll
        for (int reg = 0; reg < 16; ++reg) { o0[reg] *= alpha; o1[reg] *= alpha; lacc[reg] *= alpha; x0[reg] -= d; x1[reg] -= d; }
        u32x4 qq = {h ? 0u : (pk2(-m, 0.f) & 0xffffu), 0u, 0u, 0u}; q6 = __builtin_bit_cast(bf16x8, qq);
    }
#pragma unroll
    for (int reg = 0; reg < 16; ++reg) { x0[reg] = __builtin_amdgcn_exp2f(x0[reg]); x1[reg] = __builtin_amdgcn_exp2f(x1[reg]); }
    const bf16x8 pa0 = pack8(x0, 0), pa1 = pack8(x0, 1), pb0 = pack8(x1, 0), pb1 = pack8(x1, 1);
    const u32x4 ones_w = {ones2, ones2, ones2, ones2}; const bf16x8 ones = __builtin_bit_cast(bf16x8, ones_w);
    o0 = MFMA32(*(const bf16x8*)(vp), pa0, o0);            o1 = MFMA32(*(const bf16x8*)(vp + dts), pa0, o1);            lacc = MFMA32(ones, pa0, lacc);
    o0 = MFMA32(*(const bf16x8*)(vp + 16), pa1, o0);       o1 = MFMA32(*(const bf16x8*)(vp + dts + 16), pa1, o1);       lacc = MFMA32(ones, pa1, lacc);
    o0 = MFMA32(*(const bf16x8*)(vp + 32), pb0, o0);       o1 = MFMA32(*(const bf16x8*)(vp + dts + 32), pb0, o1);       lacc = MFMA32(ones, pb0, lacc);
    o0 = MFMA32(*(const bf16x8*)(vp + 48), pb1, o0);       o1 = MFMA32(*(const bf16x8*)(vp + dts + 48), pb1, o1);       lacc = MFMA32(ones, pb1, lacc);
}
DI void attn_store_l(const f32x16& o0, const f32x16& o1, float lt, int h, bf16_t* dst) {
    const float inv = 1.0f / lt;
#pragma unroll
    for (int g4 = 0; g4 < 4; ++g4) { u32x2 w0, w1;
        w0.x = pk2(o0[4 * g4] * inv, o0[4 * g4 + 1] * inv); w0.y = pk2(o0[4 * g4 + 2] * inv, o0[4 * g4 + 3] * inv);
        w1.x = pk2(o1[4 * g4] * inv, o1[4 * g4 + 1] * inv); w1.y = pk2(o1[4 * g4 + 2] * inv, o1[4 * g4 + 3] * inv);
        *(u32x2*)(dst + 8 * g4 + 4 * h) = w0; *(u32x2*)(dst + 32 + 8 * g4 + 4 * h) = w1; }
}
DI void attn_store(const f32x16& o0, const f32x16& o1, float l, int h, bf16_t* dst  ) {
    const float lt = l + mk_shx(l, 32), inv = 1.0f / lt;
#pragma unroll
    for (int g4 = 0; g4 < 4; ++g4) { u32x2 w0, w1;
        w0.x = pk2(o0[4 * g4] * inv, o0[4 * g4 + 1] * inv); w0.y = pk2(o0[4 * g4 + 2] * inv, o0[4 * g4 + 3] * inv);
        w1.x = pk2(o1[4 * g4] * inv, o1[4 * g4 + 1] * inv); w1.y = pk2(o1[4 * g4 + 2] * inv, o1[4 * g4 + 3] * inv);
        *(u32x2*)(dst + 8 * g4 + 4 * h) = w0; *(u32x2*)(dst + 32 + 8 * g4 + 4 * h) = w1; }
}
constexpr int GQ_P = 72, GQ_BUF = 2 * 64 * GQ_P * 2;
DI void gqa_tile(f32x16& o0, f32x16& o1, f32x2& l2, float& m, bf16x8& q4, const bf16x8 (&qf)[4], const bf16_t* Kt, bool edge, int qpos, int kpos0, int r, int h) {
    const bf16_t* Vt = Kt + 64 * GQ_P;
    const bf16_t* kp0 = Kt + r * GQ_P + 8 * h; const bf16_t* kp1 = kp0 + 32 * GQ_P;
    f32x16 S0 = zero16(), S1 = zero16();
#pragma unroll
    for (int s = 0; s < 4; ++s) { S0 = MFMA32(*(const bf16x8*)(kp0 + 16 * s), qf[s], S0); S1 = MFMA32(*(const bf16x8*)(kp1 + 16 * s), qf[s], S1); }
    S0 = MFMA32(*(const bf16x8*)(kp0 + 64), q4, S0); S1 = MFMA32(*(const bf16x8*)(kp1 + 64), q4, S1);
    if (edge) {
#pragma unroll
        for (int reg = 0; reg < 16; ++reg) { const int dd = qpos - (kpos0 + crow(reg, h)); if (dd > 128 || dd < -128) S0[reg] = -1.0e30f; if (dd > 160 || dd < -96) S1[reg] = -1.0e30f; } }
    int ti = (int)0x80000000;
#pragma unroll
    for (int reg = 0; reg < 16; ++reg) ti = imax3(ti, __float_as_int(S0[reg]), __float_as_int(S1[reg]));
    { const auto rr = __builtin_amdgcn_permlane32_swap((unsigned)ti, (unsigned)ti, false, false); const int a_ = (int)rr[0], b_ = (int)rr[1]; ti = a_ > b_ ? a_ : b_; }
    const float tmax = __int_as_float(ti);
    if (__any(tmax > 8.0f)) {
        const float mn = tmax > 8.0f ? bf16_round(m + tmax) : m, d = mn - m, alpha = __builtin_amdgcn_exp2f(-d); m = mn;
#pragma unroll
        for (int reg = 0; reg < 16; ++reg) { o0[reg] *= alpha; o1[reg] *= alpha; S0[reg] -= d; S1[reg] -= d; }
        l2 *= alpha;
        u32x4 qq = {h ? 0u : (pk2(-m, 0.f) & 0xffffu), 0u, 0u, 0u}; q4 = __builtin_bit_cast(bf16x8, qq);
    }
#pragma unroll
    for (int reg = 0; reg < 16; ++reg) { S0[reg] = __builtin_amdgcn_exp2f(S0[reg]); S1[reg] = __builtin_amdgcn_exp2f(S1[reg]); }
#pragma unroll
    for (int reg = 0; reg < 16; reg += 2) { l2 += (f32x2){S0[reg], S0[reg + 1]}; l2 += (f32x2){S1[reg], S1[reg + 1]}; }
    const bf16x8 pa0 = pack8(S0, 0), pa1 = pack8(S0, 1), pb0 = pack8(S1, 0), pb1 = pack8(S1, 1);
    const bf16_t* vp = Vt + r * GQ_P + 8 * h;
    o0 = MFMA32(*(const bf16x8*)(vp), pa0, o0);      o1 = MFMA32(*(const bf16x8*)(vp + 32 * GQ_P), pa0, o1);
    o0 = MFMA32(*(const bf16x8*)(vp + 16), pa1, o0); o1 = MFMA32(*(const bf16x8*)(vp + 32 * GQ_P + 16), pa1, o1);
    o0 = MFMA32(*(const bf16x8*)(vp + 32), pb0, o0); o1 = MFMA32(*(const bf16x8*)(vp + 32 * GQ_P + 32), pb0, o1);
    o0 = MFMA32(*(const bf16x8*)(vp + 48), pb1, o0); o1 = MFMA32(*(const bf16x8*)(vp + 32 * GQ_P + 48), pb1, o1);
}
DI void gqa_unit(const Args& a, int layer, int u, unsigned char* lds) {
    const int tid = mk_otid(), lane = tid & 63, wave = __builtin_amdgcn_readfirstlane(tid >> 6), r = lane & 31, h = lane >> 5;
    const bf16_t* P = (const bf16_t*)(a.ws + WS_P); const bf16_t* PT2 = (const bf16_t*)(a.ws + WS_PT2); bf16_t* MIX = (bf16_t*)(a.ws + WS_MIX);
    const bool lat = u < 256; const int uu = lat ? u : u - 256;
    const int b = lat ? (uu >> 7) : (uu >> 3), kvh = lat ? ((uu >> 6) & 1) : ((uu >> 2) & 1), qblk = lat ? (uu & 63) : (uu & 3);
    const int head = 4 * kvh + (wave >> 1), qt = wave & 1, t0 = 64 * qblk, qlo = t0 + 32 * qt, qrow = (lat ? 4096 * b : NLAT + 256 * b) + qlo + r;
    bf16x8 qf[4];
#pragma unroll
    for (int s = 0; s < 4; ++s) qf[s] = *(const bf16x8*)(P + (size_t)qrow * INP + 64 * head + 16 * s + 8 * h);
    const float sink = a.in[12][layer * 8 + head] * LOG2E;
    f32x16 o0 = zero16(), o1 = zero16(); float m = bf16_round(sink); f32x2 l2 = {h ? 0.f : __builtin_amdgcn_exp2f(sink - m), 0.f};
    unsigned c_one = 0x3f80u, c_zero = 0u; asm volatile("" : "+v"(c_one), "+v"(c_zero));
    bf16x8 q4; { u32x4 qq = {h ? c_zero : (pk2(-m, 0.f) & 0xffffu), c_zero, c_zero, c_zero}; q4 = __builtin_bit_cast(bf16x8, qq); }
    *(u32x4*)((bf16_t*)(lds + (tid >> 6) * GQ_BUF) + (tid & 63) * GQ_P + 64) = (u32x4){c_one, c_zero, c_zero, c_zero};
    const int bs = t0 - 128 < 0 ? 0 : t0 - 128, be = t0 + 192 > SEQ ? SEQ : t0 + 192, nt = lat ? 4 + ((be - bs) >> 6) : 4;
    const int lkey = tid >> 3, lch = tid & 7;
#define GQ_GLOAD(tn_, gk_, gv_) do { const int tc_ = (tn_) < nt ? (tn_) : nt - 1; const int krow0_ = tc_ < 4 ? NLAT + 256 * b + 64 * tc_ : 4096 * b + bs + 64 * (tc_ - 4); \
        gk_ = *(const u32x4*)(P + (size_t)(krow0_ + lkey) * INP + OFF_AK + 64 * kvh + 8 * lch); \
        gv_ = *(const u32x4*)(PT2 + (size_t)(64 * kvh + lkey) * MROWS + krow0_ + 8 * lch); } while (0)
#define GQ_LWRITE(slot_, gk_, gv_) do { bf16_t* Kn_ = (bf16_t*)(lds + (slot_) * GQ_BUF); bf16_t* Vn_ = Kn_ + 64 * GQ_P; \
        *(u32x4*)(Kn_ + lkey * GQ_P + 8 * lch) = gk_; \
        { bf16_t* vd_ = Vn_ + lkey * GQ_P + 16 * (lch >> 1) + 4 * (lch & 1); *(u32x2*)vd_ = (u32x2){gv_.x, gv_.y}; *(u32x2*)(vd_ + 8) = (u32x2){gv_.z, gv_.w}; } } while (0)
#define GQ_TILES(lo_, hi_) do { _Pragma("unroll 1") for (int t = (lo_); t < (hi_); ++t) { const int kpos0 = bs + 64 * (t - 4); \
        const bool band = t >= 4, skip = band && (kpos0 + 63 < qlo - 128 || kpos0 > qlo + 31 + 128), edge = band && (kpos0 < qlo + 31 - 128 || kpos0 + 63 > qlo + 128); \
        if (!skip) gqa_tile(o0, o1, l2, m, q4, qf, (const bf16_t*)(lds + (t & 7) * GQ_BUF), edge, qlo + r, kpos0, r, h); } } while (0)
    u32x4 k0, v0, k1, v1, k2, v2, k3, v3;
    GQ_GLOAD(0, k0, v0); GQ_GLOAD(1, k1, v1); GQ_GLOAD(2, k2, v2); GQ_GLOAD(3, k3, v3);
    GQ_LWRITE(0, k0, v0); GQ_LWRITE(1, k1, v1); GQ_LWRITE(2, k2, v2); GQ_LWRITE(3, k3, v3);
    if (lat) { GQ_GLOAD(4, k0, v0); GQ_GLOAD(5, k1, v1); GQ_GLOAD(6, k2, v2); GQ_GLOAD(7, k3, v3); }
    __syncthreads();
    GQ_TILES(0, 4);
    if (lat) {
        GQ_LWRITE(4, k0, v0); GQ_LWRITE(5, k1, v1); GQ_LWRITE(6, k2, v2); GQ_LWRITE(7, k3, v3);
        GQ_GLOAD(8, k0, v0);
        __syncthreads();
        GQ_TILES(4, nt < 8 ? nt : 8);
        if (nt > 8) { GQ_LWRITE(0, k0, v0); __syncthreads(); GQ_TILES(8, 9); }
    }
    __syncthreads();
#undef GQ_GLOAD
#undef GQ_LWRITE
#undef GQ_TILES
    attn_store(o0, o1, l2.x + l2.y, h, MIX + (size_t)qrow * DM + 64 * head);
}
constexpr int MLA_KP = 104, MLA_VP = 72, MLA_BUF = 64 * MLA_KP * 2 + 64 * MLA_VP * 2;
DI void mla_unit(const Args& a, int u, unsigned char* lds) {
    const int tid = mk_otid(), lane = tid & 63, wave = __builtin_amdgcn_readfirstlane(tid >> 6), r = lane & 31, h = lane >> 5;
    const bf16_t* P = (const bf16_t*)(a.ws + WS_P); const bf16_t* QU = (const bf16_t*)(a.ws + WS_QU); const bf16_t* KN = (const bf16_t*)(a.ws + WS_KN); const bf16_t* VT = (const bf16_t*)(a.ws + WS_VT);
    const f32x2* RM = (const f32x2*)(a.ws + WS_ROPM); bf16_t* MIX = (bf16_t*)(a.ws + WS_MIX);
    const float sl2 = 0.10206207261596577f * LOG2E;
    const bool lat = u < 256; const int uu = lat ? u : u - 256;
    const int b = lat ? (uu >> 7) : (uu >> 3), head = lat ? ((uu >> 4) & 7) : (uu & 7), qb = lat ? (uu & 15) : 0;
    const int t0 = 256 * qb + 32 * wave, qrow = (lat ? 4096 * b : NLAT + 256 * b) + t0 + r;
    bf16x8 qf[6];
#pragma unroll
    for (int s = 0; s < 6; ++s) qf[s] = *(const bf16x8*)(QU + (size_t)qrow * 768 + 96 * head + 16 * s + 8 * h);
    if (lat) {
        const int pos = t0 + r;
#pragma unroll
        for (int part = 0; part < 2; ++part) { u32x4 o; const u32x4 qv = __builtin_bit_cast(u32x4, qf[4 + part]);
#pragma unroll
            for (int w = 0; w < 4; ++w) { const float own0 = bf2f(qv[w] & 0xffffu), own1 = bf2f(qv[w] >> 16); const float oth0 = mk_shx(own0, 32), oth1 = mk_shx(own1, 32);
                const f32x2 cs0 = RM[pos * 16 + part * 8 + 2 * w], cs1 = RM[pos * 16 + part * 8 + 2 * w + 1];
                const float r0 = own0 * cs0.x + (h ? oth0 : -oth0) * cs0.y, r1 = own1 * cs1.x + (h ? oth1 : -oth1) * cs1.y; o[w] = pk2(r0, r1); }
            qf[4 + part] = __builtin_bit_cast(bf16x8, o); }
    }
    f32x16 o0 = zero16(), o1 = zero16(); f32x2 l2 = {0.f, 0.f}; float m = -1024.0f;
    unsigned c_one = 0x3f80u, c_zero = 0u; asm volatile("" : "+v"(c_one), "+v"(c_zero));
    bf16x8 q6; { u32x4 qq = {h ? c_zero : (c_one + 0x500u)  , c_zero, c_zero, c_zero}; q6 = __builtin_bit_cast(bf16x8, qq); }
    if (tid < 192) *(u32x4*)((bf16_t*)(lds + (tid >> 6) * MLA_BUF) + (tid & 63) * MLA_KP + 96) = (u32x4){c_one, c_zero, c_zero, c_zero};
    const int nt = lat ? 68 : 4;
    const int lkey = tid >> 3, lch = tid & 7, rkey = (tid >> 2) & 63, rch = tid & 3;
    u32x4 gk, gr = {0u, 0u, 0u, 0u}, gv;
#define MLA_GLOAD(tn_) do { const int tc_ = (tn_) < nt ? (tn_) : nt - 1; const int krow0_ = lat ? (tc_ < 64 ? 4096 * b + 64 * tc_ : NLAT + 256 * b + 64 * (tc_ - 64)) : NLAT + 256 * b + 64 * tc_; \
        gk = *(const u32x4*)(KN + (size_t)(krow0_ + lkey) * 512 + 64 * head + 8 * lch); \
        if (tid < 256) gr = *(const u32x4*)(P + (size_t)(krow0_ + rkey) * INP + OFF_DKR + 8 * rch); \
        gv = *(const u32x4*)(VT + (size_t)(64 * head + lkey) * MROWS + krow0_ + 8 * lch); } while (0)
#define MLA_LWRITE(slot_) do { bf16_t* Kn_ = (bf16_t*)(lds + (slot_) * MLA_BUF); bf16_t* Vn_ = Kn_ + 64 * MLA_KP; \
        *(u32x4*)(Kn_ + lkey * MLA_KP + 8 * lch) = gk; if (tid < 256) *(u32x4*)(Kn_ + rkey * MLA_KP + 64 + 8 * rch) = gr; \
        { bf16_t* vd_ = Vn_ + lkey * MLA_VP + 16 * (lch >> 1) + 4 * (lch & 1); *(u32x2*)vd_ = (u32x2){gv.x, gv.y}; *(u32x2*)(vd_ + 8) = (u32x2){gv.z, gv.w}; } } while (0)
#define MLA_QK(kp0_, N0, N1, sa_, sb_) do { _Pragma("unroll") for (int s = (sa_); s < (sb_); ++s) { const bf16x8 qq_ = s < 6 ? qf[s < 6 ? s : 0] : q6; \
        N0 = MFMA32(*(const bf16x8*)((kp0_) + 16 * s), qq_, N0); N1 = MFMA32(*(const bf16x8*)((kp0_) + 32 * MLA_KP + 16 * s), qq_, N1); } } while (0)
#define MLA_HALF(C0, C1, N0, N1, tcur_) do { \
        const int s1_ = slot == 2 ? 0 : slot + 1, s2_ = s1_ == 2 ? 0 : s1_ + 1; \
        MLA_GLOAD((tcur_) + 2); \
        const bf16_t* kn_ = (const bf16_t*)(lds + s1_ * MLA_BUF) + r * MLA_KP + 8 * h; \
        const bf16_t* vp_ = (const bf16_t*)(lds + slot * MLA_BUF) + 64 * MLA_KP + r * MLA_VP + 8 * h; \
        N0 = zero16(); N1 = zero16(); \
        MLA_QK(kn_, N0, N1, 0, 2); \
        int ti_ = (int)0x80000000; \
        _Pragma("unroll") for (int reg = 0; reg < 16; ++reg) ti_ = imax3(ti_, __float_as_int(C0[reg]), __float_as_int(C1[reg])); \
        { const auto rr_ = __builtin_amdgcn_permlane32_swap((unsigned)ti_, (unsigned)ti_, false, false); const int a_ = (int)rr_[0], b_ = (int)rr_[1]; ti_ = a_ > b_ ? a_ : b_; } \
        const float tmax_ = __int_as_float(ti_); \
        if (__any(tmax_ > 8.0f)) { \
            const float mn_ = tmax_ > 8.0f ? bf16_round(m + tmax_) : m, d_ = mn_ - m, alpha_ = __builtin_amdgcn_exp2f(-d_); m = mn_; \
            _Pragma("unroll") for (int reg = 0; reg < 16; ++reg) { o0[reg] *= alpha_; o1[reg] *= alpha_; C0[reg] -= d_; C1[reg] -= d_; } l2 *= alpha_;        \
            u32x4 qq2_ = {h ? 0u : (pk2(-m, 0.f) & 0xffffu), 0u, 0u, 0u}; q6 = __builtin_bit_cast(bf16x8, qq2_); \
        } \
        MLA_QK(kn_, N0, N1, 2, 7); \
        _Pragma("unroll") for (int reg = 0; reg < 16; ++reg) { C0[reg] = __builtin_amdgcn_exp2f(C0[reg]); C1[reg] = __builtin_amdgcn_exp2f(C1[reg]); } \
        _Pragma("unroll") for (int reg = 0; reg < 16; reg += 2) { l2 += (f32x2){C0[reg], C0[reg + 1]}; l2 += (f32x2){C1[reg], C1[reg + 1]}; } \
        { const bf16x8 pa0 = pack8(C0, 0), pa1 = pack8(C0, 1), pb0 = pack8(C1, 0), pb1 = pack8(C1, 1); \
          o0 = MFMA32(*(const bf16x8*)(vp_), pa0, o0);      o1 = MFMA32(*(const bf16x8*)(vp_ + 32 * MLA_VP), pa0, o1); \
          o0 = MFMA32(*(const bf16x8*)(vp_ + 16), pa1, o0); o1 = MFMA32(*(const bf16x8*)(vp_ + 32 * MLA_VP + 16), pa1, o1); \
          o0 = MFMA32(*(const bf16x8*)(vp_ + 32), pb0, o0); o1 = MFMA32(*(const bf16x8*)(vp_ + 32 * MLA_VP + 32), pb0, o1); \
          o0 = MFMA32(*(const bf16x8*)(vp_ + 48), pb1, o0); o1 = MFMA32(*(const bf16x8*)(vp_ + 32 * MLA_VP + 48), pb1, o1); } \
        MLA_LWRITE(s2_); \
        __syncthreads(); \
        slot = s1_; } while (0)
    MLA_GLOAD(0); MLA_LWRITE(0); MLA_GLOAD(1); MLA_LWRITE(1);
    __syncthreads();
    f32x16 A0 = zero16(), A1 = zero16(), B0, B1;
    { const bf16_t* k0_ = (const bf16_t*)lds + r * MLA_KP + 8 * h; MLA_QK(k0_, A0, A1, 0, 7); }
    int slot = 0;
#pragma unroll 1
    for (int t = 0; t < nt; t += 2) {
        MLA_HALF(A0, A1, B0, B1, t);
        MLA_HALF(B0, B1, A0, A1, t + 1);
    }
#undef MLA_GLOAD
#undef MLA_LWRITE
#undef MLA_QK
#undef MLA_HALF
    attn_store(o0, o1, l2.x + l2.y, h, MIX + (size_t)qrow * DM + 1536 + 64 * head);
}

#ifndef MK_REP_MASK
#define MK_REP_MASK 0
#endif
#define HREP(k) for (int hrep_ = 0; hrep_ < 1 + (((MK_REP_MASK) >> (k)) & 1); ++hrep_)
constexpr int HY_CST = 8224;
constexpr int HY_ZB = 5120;
DI int zoff(int t) { return (t >> 5) * 40 + (t & 31); }
DI int yoff(int t) { return t + (t >> 6) * 4; }
DI void hyena_lat_unit(const Args& a, int layer, int c, unsigned char* lds) {
    const int tid = mk_otid(), lane = tid & 63, wave = __builtin_amdgcn_readfirstlane(tid >> 6), r = lane & 31, h = lane >> 5;
    bf16_t* FC = (bf16_t*)lds; bf16_t* ZA = (bf16_t*)(lds + 65792); bf16_t* ZB = (bf16_t*)(lds + 86272); bf16_t* ZZ = (bf16_t*)(lds + 106752); bf16_t* X1 = (bf16_t*)(lds + 106912); bf16_t* X2 = (bf16_t*)(lds + 123296);
    float* Y = (float*)lds;
    const bf16_t* PT2 = (const bf16_t*)(a.ws + WS_PT2); bf16_t* HT = (bf16_t*)(a.ws + WS_HT) + (size_t)c * MROWS;
    const float* sw = a.in[13] + layer * 3 * 1536;
    if (tid < 80) ZZ[tid] = 0;
    u32x4 fr0, fr1;
    { const bf16_t* F0 = (const bf16_t*)(a.ws + WS_FILT) + ((size_t)(layer * 2) * 512 + c) * 8192; fr0 = *(const u32x4*)(F0 + 8 * tid); fr1 = *(const u32x4*)(F0 + 8 * (tid + 512)); }
    u32x4 pvs[6]; unsigned short lft[6], rgt[6];
#pragma unroll
    for (int it = 0; it < 6; ++it) { const int idx = tid + 512 * it, part = idx >> 10, bb = (idx >> 9) & 1, t0 = 8 * (idx & 511);
        const bf16_t* src = PT2 + (size_t)(128 + part * 512 + c) * MROWS + bb * 4096;
        pvs[it] = *(const u32x4*)(src + t0); lft[it] = t0 > 0 ? (unsigned short)src[t0 - 1] : (unsigned short)0; rgt[it] = t0 + 8 < 4096 ? (unsigned short)src[t0 + 8] : (unsigned short)0; }
    HREP(20)
#pragma unroll
    for (int it = 0; it < 6; ++it) { const int idx = tid + 512 * it, part = idx >> 10, bb = (idx >> 9) & 1, t0 = 8 * (idx & 511);
        const u32x4 pv = pvs[it]; const float left = bf2f(lft[it]), right = bf2f(rgt[it]);
        const float w0 = sw[part * 512 + c], w1 = sw[1536 + part * 512 + c], w2 = sw[3072 + part * 512 + c];
        float p[10]; p[0] = left; p[9] = right;
#pragma unroll
        for (int e = 0; e < 4; ++e) { p[1 + 2 * e] = bf2f(pv[e] & 0xffffu); p[2 + 2 * e] = bf2f(pv[e] >> 16); }
        u32x4 o;
#pragma unroll
        for (int e = 0; e < 4; ++e) o[e] = pk2(w0 * p[2 * e] + w1 * p[2 * e + 1] + w2 * p[2 * e + 2], w0 * p[2 * e + 1] + w1 * p[2 * e + 2] + w2 * p[2 * e + 3]);
        bf16_t* dst = part == 0 ? ZA + bb * HY_ZB + zoff(t0) : (part == 1 ? X1 : X2) + bb * 4096 + t0;
        *(u32x4*)dst = o; }
    const int ct = wave & 1, dq = wave >> 1, I = 32 * ct + r;
    const int dstart = 32 * ct - 63 + 24 * dq, nd = dq < 3 ? 24 : 23;
#pragma unroll 1
    for (int o = 0; o < 2; ++o) {
        const bf16_t* F = (const bf16_t*)(a.ws + WS_FILT) + ((size_t)(layer * 2 + o) * 512 + c) * 8192;
        __syncthreads();
        *(u32x4*)(FC + 8 * tid) = fr0; *(u32x4*)(FC + 8 * (tid + 512)) = fr1;
        if (o == 0) { fr0 = *(const u32x4*)(F + (size_t)512 * 8192 + 8 * tid); fr1 = *(const u32x4*)(F + (size_t)512 * 8192 + 8 * (tid + 512)); }
        if (tid < 4) *(u32x2*)(FC + 8192 + 4 * tid) = (u32x2){0u, 0u};
        __syncthreads();
        for (int i = tid; i < 3 * 2050; i += 512) { const int sg = 1 + i / 2050, x = 4 * (i % 2050);
            const unsigned long long lo = *(const unsigned long long*)(FC + x), hi = *(const unsigned long long*)(FC + x + 4);
            *(unsigned long long*)(FC + sg * HY_CST + x) = (lo >> (16 * sg)) | (hi << (64 - 16 * sg)); }
        __syncthreads();
        const bf16_t* zin = o ? ZB : ZA;
        f32x16 a00 = zero16(), a01 = zero16(), a10 = zero16(), a11 = zero16();
        HREP(21) { a00 = zero16(); a01 = zero16(); a10 = zero16(); a11 = zero16();
        {   const int sg = (4096 - r) & 3;
            const bf16_t* ap = FC + sg * HY_CST + (4096 - r - sg + 8 * h) - 64 * dstart;
#define HY_LOAD(dd_, PM32, PM16, P0, P16, BA0, BA1, BA2, BA3, BB0, BB1, BB2, BB3) do { const int ddc_ = (dd_) < nd ? (dd_) : nd - 1; \
                const int blk_ = I - (dstart + ddc_); const bool valid_ = (unsigned)blk_ < 64u; \
                const bf16_t* zp0_ = (valid_ ? zin + 80 * blk_ : ZZ) + 8 * h; const bf16_t* zp1_ = (valid_ ? zin + HY_ZB + 80 * blk_ : ZZ) + 8 * h; \
                const bf16_t* ad_ = ap - 64 * ddc_; \
                PM32 = ld2x8(ad_ - 32, ad_ - 28); PM16 = ld2x8(ad_ - 16, ad_ - 12); P0 = ld2x8(ad_, ad_ + 4); P16 = ld2x8(ad_ + 16, ad_ + 20); \
                BA0 = *(const bf16x8*)(zp0_); BA1 = *(const bf16x8*)(zp0_ + 16); BA2 = *(const bf16x8*)(zp0_ + 40); BA3 = *(const bf16x8*)(zp0_ + 56); \
                BB0 = *(const bf16x8*)(zp1_); BB1 = *(const bf16x8*)(zp1_ + 16); BB2 = *(const bf16x8*)(zp1_ + 40); BB3 = *(const bf16x8*)(zp1_ + 56); } while (0)
#define HY_MMA(PM32, PM16, P0, P16, BA0, BA1, BA2, BA3, BB0, BB1, BB2, BB3) do { \
                a00 = MFMA32(P0, BA0, a00); a01 = MFMA32(P0, BB0, a01); a10 = MFMA32(PM32, BA0, a10); a11 = MFMA32(PM32, BB0, a11); \
                a00 = MFMA32(P16, BA1, a00); a01 = MFMA32(P16, BB1, a01); a10 = MFMA32(PM16, BA1, a10); a11 = MFMA32(PM16, BB1, a11); \
                a00 = MFMA32(c32, BA2, a00); a01 = MFMA32(c32, BB2, a01); a10 = MFMA32(P0, BA2, a10); a11 = MFMA32(P0, BB2, a11); \
                a00 = MFMA32(c48, BA3, a00); a01 = MFMA32(c48, BB3, a01); a10 = MFMA32(P16, BA3, a10); a11 = MFMA32(P16, BB3, a11); \
                c32 = PM32; c48 = PM16; } while (0)
#define HY_ILV do { _Pragma("unroll") for (int i_ = 0; i_ < 16; ++i_) { __builtin_amdgcn_sched_group_barrier(0x008, 1, 0); __builtin_amdgcn_sched_group_barrier(0x100, 1, 0); } } while (0)
            bf16x8 c32 = ld2x8(ap + 32, ap + 36), c48 = ld2x8(ap + 48, ap + 52);
            bf16x8 e0, e1, e2, e3, e4, e5, e6, e7, e8, e9, e10, e11, f0, f1, f2, f3, f4, f5, f6, f7, f8, f9, f10, f11;
            HY_LOAD(0, e0, e1, e2, e3, e4, e5, e6, e7, e8, e9, e10, e11);
#pragma unroll 1
            for (int dd = 0; dd < nd; dd += 2) {
                HY_LOAD(dd + 1, f0, f1, f2, f3, f4, f5, f6, f7, f8, f9, f10, f11);
                HY_MMA(e0, e1, e2, e3, e4, e5, e6, e7, e8, e9, e10, e11);
                HY_ILV;
                if (dd + 1 < nd) {
                    HY_LOAD(dd + 2, e0, e1, e2, e3, e4, e5, e6, e7, e8, e9, e10, e11);
                    HY_MMA(f0, f1, f2, f3, f4, f5, f6, f7, f8, f9, f10, f11);
                    HY_ILV;
                }
            }
#undef HY_LOAD
#undef HY_ILV
#undef HY_MMA
        }
        asm volatile("" : "+v"(a00), "+v"(a01), "+v"(a10), "+v"(a11)); }
        __syncthreads();
#pragma unroll 1
        for (int k = 0; k < 4; ++k) {
            if (dq == k) {
#pragma unroll
                for (int g4 = 0; g4 < 4; ++g4) { const int tb = 64 * I + 8 * g4 + 4 * h;
                    float* y00 = Y + yoff(tb), *y10 = Y + yoff(tb + 32), *y01 = y00 + 4352, *y11 = y10 + 4352;
                    f32x4 v00 = {a00[4 * g4], a00[4 * g4 + 1], a00[4 * g4 + 2], a00[4 * g4 + 3]}, v01 = {a01[4 * g4], a01[4 * g4 + 1], a01[4 * g4 + 2], a01[4 * g4 + 3]};
                    f32x4 v10 = {a10[4 * g4], a10[4 * g4 + 1], a10[4 * g4 + 2], a10[4 * g4 + 3]}, v11 = {a11[4 * g4], a11[4 * g4 + 1], a11[4 * g4 + 2], a11[4 * g4 + 3]};
                    if (k > 0) { v00 += *(const f32x4*)y00; v01 += *(const f32x4*)y01; v10 += *(const f32x4*)y10; v11 += *(const f32x4*)y11; }
                    *(f32x4*)y00 = v00; *(f32x4*)y01 = v01; *(f32x4*)y10 = v10; *(f32x4*)y11 = v11; }
            }
            __syncthreads();
        }
        const float bias = a.in[20][(layer * 2 + o) * 512 + c], inrm = 1.0f / ((const float*)(a.ws + WS_FNORM))[(layer * 2 + o) * 512 + c];
#pragma unroll
        for (int k = 0; k < 4; ++k) { const int q = tid + 512 * k, bb = q >> 10, t0 = 4 * (q & 1023);
            const f32x4 yv = *(const f32x4*)(Y + bb * 4352 + yoff(t0));
            const u32x2 zp = *(const u32x2*)(zin + bb * HY_ZB + zoff(t0)), xg = *(const u32x2*)((o ? X2 : X1) + bb * 4096 + t0);
            const float z[4] = {bf2f(zp.x & 0xffffu), bf2f(zp.x >> 16), bf2f(zp.y & 0xffffu), bf2f(zp.y >> 16)}, xv[4] = {bf2f(xg.x & 0xffffu), bf2f(xg.x >> 16), bf2f(xg.y & 0xffffu), bf2f(xg.y >> 16)};
            float y[4];
#pragma unroll
            for (int e = 0; e < 4; ++e) y[e] = xv[e] * (yv[e] * inrm + bias * z[e]);
            u32x2 w; w.x = pk2(y[0], y[1]); w.y = pk2(y[2], y[3]);
            if (o == 0) *(u32x2*)(ZB + bb * HY_ZB + zoff(t0)) = w; else *(u32x2*)(HT + bb * 4096 + t0) = w; }
    }
    __syncthreads();
}
DI void hyena_ctx_unit(const Args& a, int layer, int c, unsigned char* lds) {
    const int tid = mk_otid(), bb = tid >> 8, t = tid & 255;
    float* G0 = (float*)lds; float* G1 = G0 + 640; float* zv = G0 + 1280; float* x1 = G0 + 1792; float* x2 = G0 + 2304; float* z1 = G0 + 2816; float* part = G0 + 3328;
    const bf16_t* PT2 = (const bf16_t*)(a.ws + WS_PT2); bf16_t* HT = (bf16_t*)(a.ws + WS_HT) + (size_t)c * MROWS;
    const float* FCX = (const float*)(a.ws + WS_FILTC); const float* sw = a.in[13] + layer * 3 * 1536;
    const float* FN = (const float*)(a.ws + WS_FNORM) + (4 + layer) * 2 * 512;
    G0[tid + (tid >> 2)] = FCX[((size_t)(layer * 2 + 0) * 512 + c) * 512 + tid]; G1[tid + (tid >> 2)] = FCX[((size_t)(layer * 2 + 1) * 512 + c) * 512 + tid];
    float uo[3];
#pragma unroll
    for (int part_ = 0; part_ < 3; ++part_) { const bf16_t* src = PT2 + (size_t)(128 + part_ * 512 + c) * MROWS + NLAT + 256 * bb;
        const float pm1 = t > 0 ? bf2f(src[t - 1]) : 0.f, p0 = bf2f(src[t]), pp1 = t < 255 ? bf2f(src[t + 1]) : 0.f;
        uo[part_] = sw[part_ * 512 + c] * pm1 + sw[1536 + part_ * 512 + c] * p0 + sw[3072 + part_ * 512 + c] * pp1; }
    zv[tid] = uo[0]; x1[tid] = uo[1]; x2[tid] = uo[2];
    const int sh = tid >> 7, b2 = (tid >> 6) & 1, t4 = 4 * (tid & 63);
#pragma unroll 1
    for (int o = 0; o < 2; ++o) {
        __syncthreads();
        const float* Gf = o ? G1 : G0; const float* zz = (o ? z1 : zv) + b2 * 256;
        float y0 = 0.f, y1 = 0.f, y2 = 0.f, y3 = 0.f;
        const int s_lo = 64 * sh;
#pragma unroll 4
        for (int s = s_lo; s < s_lo + 64; s += 4) { const f32x4 z4 = *(const f32x4*)(zz + s); const int x0 = 256 - t4 + s - 3; const float* gp = Gf + x0 + (x0 >> 2);
            const float g0 = gp[0], g1 = gp[1], g2 = gp[2], g3 = gp[4], g4 = gp[5], g5 = gp[6], g6 = gp[7];
            y0 += g3 * z4[0] + g4 * z4[1] + g5 * z4[2] + g6 * z4[3];
            y1 += g2 * z4[0] + g3 * z4[1] + g4 * z4[2] + g5 * z4[3];
            y2 += g1 * z4[0] + g2 * z4[1] + g3 * z4[2] + g4 * z4[3];
            y3 += g0 * z4[0] + g1 * z4[1] + g2 * z4[2] + g3 * z4[3]; }
        *(f32x4*)(part + sh * 512 + b2 * 256 + t4) = (f32x4){y0, y1, y2, y3};
        __syncthreads();
        const float y = ((part[tid] + part[512 + tid]) + (part[1024 + tid] + part[1536 + tid])) / FN[o * 512 + c];
        if (o == 0) z1[tid] = uo[1] * (y + a.in[20][(layer * 2 + 0) * 512 + c] * uo[0]);
        else HT[NLAT + 256 * bb + t] = f2bf(uo[2] * (y + a.in[20][(layer * 2 + 1) * 512 + c] * z1[tid]));
    }
    __syncthreads();
}

constexpr int PH_PRO_A = 0, PH_PRO_B = 1, PH_L0 = 2, PH_PER_LAYER = 11, N_PHASES = PH_L0 + DEPTH * PH_PER_LAYER;
__host__ __device__ inline bool phase_active(int ph) {
    if (ph < PH_L0) return true;
    const int layer = (ph - PH_L0) / PH_PER_LAYER, k = (ph - PH_L0) % PH_PER_LAYER;
    if (k == 0) return layer == 0;
    if (k == 7) return (layer & 1) != 0;
    return true;
}

__global__ void __launch_bounds__(512, 2) mega(Args a) {
    extern __shared__ __attribute__((aligned(16))) unsigned char lds[];
    const int tid = mk_otid(), G = gridDim.x;
    PG8_LAS unsigned char* ldsl = (PG8_LAS unsigned char*)lds;
    volatile LAS unsigned* MISC = (volatile LAS unsigned*)(ldsl + MISC_OFF);
    if (tid < 64) MISC[tid] = 0u;
    __syncthreads();
    unsigned char* ws = a.ws;
    XcdBarrier bar = xcd_barrier_post((unsigned*)(ws + WS_CTL) + CW_BAR, MISC);
    const int lo = a.ph_lo, hi = a.ph_hi;
#ifndef MK_PHMASK
#define MK_PHMASK 0xffff
#endif
#define EN(k) (((MK_PHMASK) >> (k)) & 1)
#ifndef MK_SUB
#define MK_SUB 0xff
#endif
#define SUB(k) (((MK_SUB) >> (k)) & 1)
#ifndef MK_REP_MASK
#define MK_REP_MASK 0
#endif
#define REP(k) for (int rep_ = 0; rep_ < 1 + (((MK_REP_MASK) >> (k)) & 1); ++rep_)
#define IN(k) (lo <= (k) && (k) < hi)
#define SEAM(k) do { if ((k) + 1 < hi) xcd_barrier(bar); } while (0)
    bf16_t* XB = (bf16_t*)(ws + WS_X);     bf16_t* HA = (bf16_t*)(ws + WS_HA); bf16_t* P = (bf16_t*)(ws + WS_P); bf16_t* MIX = (bf16_t*)(ws + WS_MIX); bf16_t* Y = (bf16_t*)(ws + WS_Y);
    const float* MOD = (const float*)(ws + WS_MOD);

    if (EN(11) && IN(PH_PRO_A)) { REP(11) phase_pro_a(a, lds); SEAM(PH_PRO_A); }
    if (EN(12) && IN(PH_PRO_B)) { REP(12) phase_pro_b(a, lds); SEAM(PH_PRO_B); }

#pragma unroll 1
    for (int layer = 0; layer < DEPTH; ++layer) {
        const int pb = PH_L0 + layer * PH_PER_LAYER;
        if (pb + PH_PER_LAYER <= lo || pb >= hi) continue;
        const bool ctx_out = layer < DEPTH - 1, moe = (layer & 1) != 0;
        const int nrows = ctx_out ? MROWS : NLAT;
        const float* modl = MOD + (size_t)layer * 3 * 12288;
        asm volatile("; MKPHASE 0" ::: "memory");
        if (EN(0) && IN(pb + 0) && layer == 0) {
            NormP p{}; p.xin_lat = a.in[0]; p.xin_ctx = a.in[2]; p.nrows = MROWS; p.mod_shift = modl; p.mod_scale = modl + 2048; p.gpre = a.in[6]; p.ha = HA;
            norm_phase<false, false, true, false, false>(p, lds); SEAM(pb + 0);
        }
        asm volatile("; MKPHASE 1" ::: "memory");
        if (EN(1) && IN(pb + 1)) {
            REP(1) {
            pg8::Gemm g{HA, (const bf16_t*)(ws + WS_WIN) + (size_t)layer * INP * DM, MROWS, INP, DM}; pg8::StaticOrder S; S.init(MROWS, INP, G, (int)blockIdx.x);
            pg8::EpiStore E{P, INP, 1 << 20};
            pg8::gemm_phase<pg8::EpiStore, pg8::StaticOrder, true, true>(ldsl, g, S, E);
            }
            SEAM(pb + 1);
        }
        asm volatile("; MKPHASE 2" ::: "memory");
        if (EN(2) && IN(pb + 2)) {
            REP(17) { for (int u = blockIdx.x; u < 8 * NCHK; u += G) mlstm_step1_unit(a, layer, u, lds); }
            REP(18) task_transpose((const bf16_t*)(ws + WS_P) + OFF_AV, INP, (bf16_t*)(ws + WS_PT2), MROWS, 136, 26, lds);
            task_rope(a);
            REP(18) task_mla_norm(a, layer);
            SEAM(pb + 2);
        }
        asm volatile("; MKPHASE 3" ::: "memory");
        if (EN(3) && IN(pb + 3)) {
            REP(3) {
            if (SUB(0)) {
                const int mq = ctx_out ? MROWS : NLAT, nuq = (mq / 256) * 3;
                const bf16_t* wkv = (const bf16_t*)(ws + WS_WUKV) + (size_t)layer * 1024 * 256;
                pg8::Gemm gq{(const bf16_t*)(ws + WS_QN), (const bf16_t*)(ws + WS_WUQ) + (size_t)layer * 768 * 512, mq, 768, 512}; pg8::StaticOrder Sq; Sq.init(mq, 768, G, (int)blockIdx.x);
                pg8::EpiStore Eq{(bf16_t*)(ws + WS_QU), 768, 1 << 20};
                pg8::gemm_phase<pg8::EpiStore, pg8::StaticOrder, true, true>(ldsl, gq, Sq, Eq);
                pg8::Gemm gk{(const bf16_t*)(ws + WS_KVN), wkv, MROWS, 512, 256}; pg8::StaticOrder Sk; Sk.init(MROWS, 512, G, (int)((blockIdx.x + G - nuq) % G));
                pg8::EpiStore Ek{(bf16_t*)(ws + WS_KN), 512, 1 << 20};
                pg8::gemm_phase<pg8::EpiStore, pg8::StaticOrder, true, true>(ldsl, gk, Sk, Ek);
                pg8::Gemm gv{wkv + (size_t)512 * 256, (const bf16_t*)(ws + WS_KVN), 512, MROWS, 256}; pg8::StaticOrder Sv; Sv.init(512, MROWS, G, (int)((blockIdx.x + 2 * G - nuq - 68) % G));
                pg8::EpiStore Ev{(bf16_t*)(ws + WS_VT), MROWS, 1 << 20};
                pg8::gemm_phase<pg8::EpiStore, pg8::StaticOrder, true, true>(ldsl, gv, Sv, Ev);
            }
            __syncthreads();
            if (SUB(1)) REP(13) for (int c = blockIdx.x; c < 512; c += G) hyena_lat_unit(a, layer, c, lds);
            if (SUB(2) && ctx_out) for (int c = blockIdx.x; c < 512; c += G) hyena_ctx_unit(a, layer, c, lds);
            if (SUB(3)) REP(14) { const int bx = (int)blockIdx.x, xc = bx & 7, li = bx >> 3;
              if (G == 256) { gqa_unit(a, layer, (xc >> 1) * 64 + (xc & 1) * 32 + li, lds); if (ctx_out && bx >= 240) gqa_unit(a, layer, 256 + (xc >> 1) * 4 + (xc & 1) * 2 + (li - 30), lds); }
              else { for (int u = bx; u < 256; u += G) gqa_unit(a, layer, u, lds); if (ctx_out) for (int u = 256 + bx; u < 272; u += G) gqa_unit(a, layer, u, lds); } }
            if (SUB(4)) REP(19) task_mlstm_scan(a);
            }
            SEAM(pb + 3);
        }
        asm volatile("; MKPHASE 4" ::: "memory");
        if (EN(4) && IN(pb + 4)) {
            REP(4) {
            REP(15) for (int u = blockIdx.x; u < 8 * NCHK; u += G) { if (!ctx_out && (u % NCHK) < 2) continue; mlstm_step3_unit(a, layer, u, lds); }
            task_transpose((const bf16_t*)(ws + WS_HT), MROWS, MIX + 512, DM, 8, nrows / 64, lds);
            __syncthreads();
            REP(16) { const int bx = (int)blockIdx.x, li = bx >> 3, pr = 2 * (bx & 7) + (li >> 4);
              if (G == 256) { mla_unit(a, pr * 16 + (li & 15), lds); if (ctx_out && bx >= 16 && bx < 32) mla_unit(a, 256 + 2 * (bx & 7) + ((bx >> 3) & 1), lds); }
              else { for (int u = bx; u < 256; u += G) mla_unit(a, u, lds); if (ctx_out) for (int u = 256 + bx; u < 272; u += G) mla_unit(a, u, lds); } }
            }
            SEAM(pb + 4);
        }
        asm volatile("; MKPHASE 5" ::: "memory");
        if (EN(5) && IN(pb + 5)) {
            REP(5) {
            const bf16_t* wo = (const bf16_t*)(ws + WS_WOUT) + (size_t)layer * DM * DM;
            { pg8::Gemm g{MIX, wo, NLAT, DM, DM, 0}; pg8::StaticOrder S; S.init(NLAT, DM, G, (int)blockIdx.x);
              pg8::EpiStore E{Y, DM, 1 << 20, 0};
              pg8::gemm_phase<pg8::EpiStore, pg8::StaticOrder, true, true>(ldsl, g, S, E); }
            if (ctx_out) { pg8::Gemm g{MIX + (size_t)NLAT * DM, wo, NCTX, DM, 256, DM}; pg8::SplitOrder S{2, 8, 8, 256 * 2, G, (int)blockIdx.x};
              pg8::EpiStore E{(bf16_t*)(ws + WS_YC), DM, 1 << 20, (size_t)NCTX * DM};
              pg8::gemm_phase<pg8::EpiStore, pg8::SplitOrder, false, true>(ldsl, g, S, E); }
            }
            SEAM(pb + 5);
        }
        asm volatile("; MKPHASE 6" ::: "memory");
        if (EN(6) && IN(pb + 6)) {
            NormP p{}; p.xin_lat = layer == 0 ? a.in[0] : (const float*)XB; p.xin_ctx = layer == 0 ? a.in[2] : (const float*)(XB + (size_t)NLAT * DM); p.xout_lat = (float*)XB; p.xout_ctx = (float*)(XB + (size_t)NLAT * DM); p.nrows = nrows; p.xin_b16 = layer != 0; p.xout_b16 = 1;
            p.ysrc = Y; p.yctx = (const bf16_t*)(ws + WS_YC); p.nsc = 8; p.mod_gate = modl + 2 * 2048; p.gpost = a.in[7] + layer * DM; p.mod_shift = modl + 3 * 2048; p.mod_scale = modl + 4 * 2048; p.gpre = a.in[8] + layer * DM; p.ha = HA;
            if (moe) { p.router = a.in[30] + (size_t)(layer >> 1) * DM * 8; p.route_out = (f32x4*)(ws + WS_ROUTE); p.hist_out = (int*)(ws + WS_HIST); }
            p.ha8 = 1;
            REP(6) { NormP q = p; if (((MK_REP_MASK) >> 6) & 1) { if (rep_ == 0) { q.xout_lat = (float*)(ws + WS_YS); q.xout_ctx = (float*)((bf16_t*)(ws + WS_YS) + (size_t)NLAT * DM); } }
              if (moe) norm_phase<true, false, true, true, true>(q, lds); else if (layer == 0) norm_phase<true, false, true, false, false>(q, lds); else norm_phase<true, false, true, false, true>(q, lds); }
            SEAM(pb + 6);
        }
        asm volatile("; MKPHASE 7" ::: "memory");
        if (EN(7) && IN(pb + 7) && moe) { phase_gather(a, nrows, lds); SEAM(pb + 7); }
        asm volatile("; MKPHASE 8" ::: "memory");
        if (EN(8) && IN(pb + 8)) {
            REP(8) {
            if (moe) {
                pg8::GroupedOrder S; moe_tiles(a, lds, S); S.nN = 22; S.nwg = S.nM * 22; S.G = G; S.c = (int)blockIdx.x;
                pg8::Gemm g{(const bf16_t*)(ws + WS_HG), (const bf16_t*)(ws + WS_WGUE + (size_t)(layer >> 1) * 8 * 2 * EXPD * DM), 0, 0, DM, 0, SC_H8, SC_W8};
                pg8::EpiSwiGLU E{(bf16_t*)(ws + WS_H), EXPD, 22, 1};
                pg8::gemm_phase<pg8::EpiSwiGLU, pg8::GroupedOrder, true, true, 1>(ldsl, g, S, E);
            } else {
                pg8::Gemm g{HA, (const bf16_t*)(ws + WS_WGU + (size_t)(layer >> 1) * 2 * FFN * DM), nrows, 2 * FFN, DM, 0, SC_H8, SC_W8}; pg8::StaticOrder S; S.init(nrows, 2 * FFN, G, (int)blockIdx.x);
                pg8::EpiSwiGLU E{(bf16_t*)(ws + WS_H), FFN, 1 << 20, 1};
                pg8::gemm_phase<pg8::EpiSwiGLU, pg8::StaticOrder, true, true, 1>(ldsl, g, S, E);
            }
            }
            SEAM(pb + 8);
        }
        asm volatile("; MKPHASE 9" ::: "memory");
        if (EN(9) && IN(pb + 9)) {
            REP(9) {
            if (moe) {
                pg8::GroupedOrder S; moe_tiles(a, lds, S); S.nN = 8; S.nwg = S.nM * 8; S.G = G; S.c = (int)blockIdx.x;
                pg8::Gemm g{(const bf16_t*)(ws + WS_H), (const bf16_t*)(ws + WS_WDNE + (size_t)(layer >> 1) * 8 * DM * EXPD), 0, 0, EXPD, 0, SC_H8, SC_W8};
                pg8::EpiStore E{(bf16_t*)(ws + WS_YS), DM, 8};
                pg8::gemm_phase<pg8::EpiStore, pg8::GroupedOrder, true, true, 1>(ldsl, g, S, E);
            } else {
                const bf16_t* wd = (const bf16_t*)(ws + WS_WDN + (size_t)(layer >> 1) * DM * FFN);
                { pg8::Gemm g{(const bf16_t*)(ws + WS_H), wd, NLAT, DM, FFN, 0, SC_H8, SC_W8}; pg8::StaticOrder S; S.init(NLAT, DM, G, (int)blockIdx.x);
                  pg8::EpiStore E{Y, DM, 1 << 20, 0};
                  pg8::gemm_phase<pg8::EpiStore, pg8::StaticOrder, true, true, 1>(ldsl, g, S, E); }
                { pg8::Gemm g{(const bf16_t*)(ws + WS_H + (size_t)NLAT * FFN), wd, NCTX, DM, 512, FFN, SC_H8, SC_W8}; pg8::SplitOrder S{2, 8, 11, 512, G, (int)blockIdx.x};
                  pg8::EpiStore E{(bf16_t*)(ws + WS_YC), DM, 1 << 20, (size_t)NCTX * DM};
                  pg8::gemm_phase<pg8::EpiStore, pg8::SplitOrder, true, true, 1>(ldsl, g, S, E); }
            }
            }
            SEAM(pb + 9);
        }
        asm volatile("; MKPHASE 10" ::: "memory");
        if (EN(10) && IN(pb + 10)) {
            NormP p{}; p.xin_lat = (const float*)XB; p.xin_ctx = (const float*)(XB + (size_t)NLAT * DM); p.xin_b16 = 1; p.nrows = nrows; p.mod_gate = modl + 5 * 2048; p.gpost = a.in[9] + layer * DM;
            if (ctx_out) { p.xout_lat = (float*)XB; p.xout_ctx = (float*)(XB + (size_t)NLAT * DM); p.xout_b16 = 1; const float* modn = modl + 3 * 12288; p.mod_shift = modn; p.mod_scale = modn + 2048; p.gpre = a.in[6] + (layer + 1) * DM; p.ha = HA; }
            else { p.xout_lat = a.out; p.xout_ctx = a.out; }
            if (moe) { p.ysrc = (const bf16_t*)(ws + WS_YS); p.slot = (const int*)(ws + WS_SLOT); p.route = (const f32x4*)(ws + WS_ROUTE);
                if (ctx_out) norm_phase<true, true, true, false>(p, lds); else norm_phase<true, true, false, false>(p, lds); }
            else { p.ysrc = Y; p.yctx = (const bf16_t*)(ws + WS_YC); p.nsc = 11; norm_phase<true, false, true, false>(p, lds); }
            SEAM(pb + 10);
        }
    }
#undef IN
#undef SEAM
}
}

#ifndef MK_ONE_LAUNCH
#define MK_ONE_LAUNCH 1
#endif
extern "C" void kernel_launch(void* const* d_in, const int* in_sizes, int n_in, void* d_out, int out_size, void* d_ws, size_t ws_size, hipStream_t stream) {
    using namespace mk;
    static int grid = 0;
    if (grid == 0) {
        if (n_in != 34 || ws_size < WS_END) { fprintf(stderr, "kernel_launch: expected 34 inputs and >= %zu bytes of workspace; got %d, %zu\n", (size_t)WS_END, n_in, ws_size); grid = -1; return; }
        if (hipFuncSetAttribute((const void*)mega, hipFuncAttributeMaxDynamicSharedMemorySize, LDS_BYTES) != hipSuccess) { fprintf(stderr, "kernel_launch: hipFuncSetAttribute failed\n"); grid = -1; return; }
        int per_cu = 0;
        if (hipOccupancyMaxActiveBlocksPerMultiprocessor(&per_cu, (const void*)mega, 512, LDS_BYTES) != hipSuccess || per_cu < 1) fprintf(stderr, "kernel_launch: occupancy query says %d\n", per_cu);
        (void)hipGetLastError();
        grid = 256;
    }
    if (grid < 0) return;
    (void)hipMemsetAsync((char*)d_ws + WS_CTL, 0, CTL_BYTES, stream);
    Args a{};
    for (int i = 0; i < 34; ++i) a.in[i] = (const float*)d_in[i];
    a.out = (float*)d_out; a.ws = (unsigned char*)d_ws;
#if MK_ONE_LAUNCH
    a.ph_lo = 0; a.ph_hi = N_PHASES;
    hipLaunchKernelGGL(mega, dim3(grid), dim3(512), LDS_BYTES, stream, a);
#else
    for (int ph = 0; ph < N_PHASES; ++ph) { if (!phase_active(ph)) continue; a.ph_lo = ph; a.ph_hi = ph + 1; hipLaunchKernelGGL(mega, dim3(grid), dim3(512), LDS_BYTES, stream, a); }
#endif
}
```

```cpp
#include <hip/hip_runtime.h>
#include <cstdio>
#include <cstdint>

#define DI __device__ __forceinline__
#define LAS __attribute__((address_space(3)))
__device__ __forceinline__ int mk_otid() { int t = (int)threadIdx.x; asm volatile("" : "+v"(t)); return t; }
__device__ __forceinline__ float mk_shx(float v, int mask) { int lane = (int)__builtin_amdgcn_mbcnt_hi(~0u, __builtin_amdgcn_mbcnt_lo(~0u, 0u)); asm volatile("" : "+v"(lane)); return __int_as_float(__builtin_amdgcn_ds_bpermute((lane ^ mask) << 2, __float_as_int(v))); }

namespace pg8 {
#define PG8_LAS __attribute__((address_space(3)))
typedef unsigned short bf16_t;
typedef short bf16x8 __attribute__((ext_vector_type(8)));
typedef float f32x4 __attribute__((ext_vector_type(4)));
typedef unsigned u32x4 __attribute__((ext_vector_type(4)));
constexpr int BM = 256, BK = 64, HALF = 128, HTB = HALF * BK * 2  , STAGE_BYTES = 8 * HTB, NXCD = 8, WGM = 8;

__host__ __device__ __forceinline__ int lds_byte(int r, int c) { const int st = (r >> 4) * 2 + (c >> 5), rr = r & 15, cc = c & 31, ob = rr * 64 + cc * 2; return st * 1024 + (ob ^ (((ob >> 9) & 1) << 5)); }
__host__ __device__ __forceinline__ void stage_rc(int b, int& R, int& C) { const int st = b / 1024, sb = b % 1024, swz = sb ^ (((sb >> 9) & 1) << 5); R = (st >> 1) * 16 + swz / 64; C = (st & 1) * 32 + (swz % 64) / 2; }
__host__ __device__ __forceinline__ int perm32(int rho) { const int n = rho >> 4, i = rho & 15; return 8 * (i >> 2) + 4 * n + (i & 3); }

struct Unit { int pm, pn, ko, ks; };
struct Gemm { const bf16_t* A; const bf16_t* Bt; int M, N, K, ld; int sa, sb; };

struct StaticOrder {
    int nM, nN, nwg, G, c;
    __host__ __device__ void init(int M, int N, int G_, int c_) { nM = M / BM; nN = N / BM; nwg = nM * nN; G = G_; c = c_; }
    __host__ __device__ bool next(int i, Unit& u) const {
        const long L = (long)i * G + c; if (L >= nwg) return false;
        int wgid = (int)L; { const int q = nwg / NXCD, r = nwg % NXCD, xcd = wgid % NXCD, off = wgid / NXCD; wgid = (xcd < r ? xcd * (q + 1) : r * (q + 1) + (xcd - r) * q) + off; }
        const int nig = WGM * nN, gid = wgid / nig, fm = gid * WGM, gsz = (nM - fm) < WGM ? (nM - fm) : WGM;
        u.pm = fm + ((wgid % nig) % gsz); u.pn = (wgid % nig) / gsz; u.ko = 0; u.ks = 0; return true;
    }
    __device__ __forceinline__ void a_ready(const Unit&) const {}
    __device__ __forceinline__ void done(const Unit&) const {}
};
struct SplitOrder {
    int nM, nN, ns, kb, G, c;
    __device__ __forceinline__ bool next(int i, Unit& u) const {
        const int L = i * G + c, nt = nM * nN; if (L >= nt * ns) return false;
        const int s = L / nt, t = L % nt; u.pm = t / nN; u.pn = t % nN; u.ks = s; u.ko = s * kb; return true;
    }
    __device__ __forceinline__ void a_ready(const Unit&) const {}
    __device__ __forceinline__ void done(const Unit&) const {}
};
struct GroupedOrder {
    int nM, nN, nwg, G, c; int s1, s2, s3, s4, s5, s6, s7;
    __device__ __forceinline__ bool next(int i, Unit& u) const {
        const long L = (long)i * G + c; if (L >= nwg) return false;
        int wgid = (int)L; { const int q = nwg / NXCD, r = nwg % NXCD, xcd = wgid % NXCD, off = wgid / NXCD; wgid = (xcd < r ? xcd * (q + 1) : r * (q + 1) + (xcd - r) * q) + off; }
        const int nig = WGM * nN, gid = wgid / nig, fm = gid * WGM, gsz = (nM - fm) < WGM ? (nM - fm) : WGM;
        const int pm = fm + ((wgid % nig) % gsz), pl = (wgid % nig) / gsz;
        const int e = (pm >= s1) + (pm >= s2) + (pm >= s3) + (pm >= s4) + (pm >= s5) + (pm >= s6) + (pm >= s7);
        u.pm = pm; u.pn = e * nN + pl; u.ko = 0; u.ks = 0; return true;
    }
    __device__ __forceinline__ void a_ready(const Unit&) const {}
    __device__ __forceinline__ void done(const Unit&) const {}
};

typedef float f32x2_t __attribute__((ext_vector_type(2))); typedef __bf16 bf16x2_t __attribute__((ext_vector_type(2)));
__device__ __forceinline__ unsigned cvt_pk_bf16(float lo, float hi) { f32x2_t v = {lo, hi}; bf16x2_t b = __builtin_convertvector(v, bf16x2_t); return __builtin_bit_cast(unsigned, b); }

struct EpiStore {
    static constexpr bool PERM = true, AFTER_DRAIN = false;
    bf16_t* O; int ldc; int nct; size_t sstride;
    __device__ __forceinline__ void operator()(const f32x4 (&acc)[2][2][4][2], const Unit& u, int wr, int wc, int fr, int fq) const {
        const int row0 = u.pm * BM + wr * 64 + fr; const int col0 = (u.pn % nct) * BM + wc * 32 + 8 * fq;
        bf16_t* Ob = O + (size_t)u.ks * sstride;
#pragma unroll
        for (int ai = 0; ai < 2; ++ai)
#pragma unroll
            for (int m = 0; m < 4; ++m) { bf16_t* rowp = Ob + (size_t)(row0 + ai * HALF + m * 16) * ldc + col0;
#pragma unroll
                for (int bj = 0; bj < 2; ++bj) { const f32x4 v0 = acc[ai][bj][m][0], v1 = acc[ai][bj][m][1];
                    u32x4 w; w.x = cvt_pk_bf16(v0[0], v0[1]); w.y = cvt_pk_bf16(v0[2], v0[3]); w.z = cvt_pk_bf16(v1[0], v1[1]); w.w = cvt_pk_bf16(v1[2], v1[3]);
                    *(u32x4*)(rowp + bj * HALF) = w; } }
    }
};
struct EpiSwiGLU {
    static constexpr bool PERM = true, AFTER_DRAIN = false;
    bf16_t* H; int ldh; int nct; int f8;
    __device__ __forceinline__ void operator()(const f32x4 (&acc)[2][2][4][2], const Unit& u, int wr, int wc, int fr, int fq) const {
        const int row0 = u.pm * BM + wr * 64 + fr; const int col0 = (u.pn % nct) * HALF + wc * 32 + 8 * fq;
#pragma unroll
        for (int ai = 0; ai < 2; ++ai)
#pragma unroll
            for (int m = 0; m < 4; ++m) { bf16_t* rowp = H + (size_t)(row0 + ai * HALF + m * 16) * ldh + col0;
                float h[8];
#pragma unroll
                for (int n = 0; n < 2; ++n)
#pragma unroll
                    for (int e = 0; e < 4; ++e) { const float g = acc[ai][0][m][n][e], up = acc[ai][1][m][n][e];
                        h[n * 4 + e] = g * __builtin_amdgcn_rcpf(1.0f + __expf(-g)) * up; }
                if (f8) { float c8[8];
#pragma unroll
                    for (int i = 0; i < 8; ++i) c8[i] = fminf(fmaxf(h[i] * 8.0f, -448.0f), 448.0f);
                    int p0 = __builtin_amdgcn_cvt_pk_fp8_f32(c8[0], c8[1], 0, false); p0 = __builtin_amdgcn_cvt_pk_fp8_f32(c8[2], c8[3], p0, true);
                    int p1 = __builtin_amdgcn_cvt_pk_fp8_f32(c8[4], c8[5], 0, false); p1 = __builtin_amdgcn_cvt_pk_fp8_f32(c8[6], c8[7], p1, true);
                    typedef unsigned pg8_u2 __attribute__((ext_vector_type(2)));
                    *(pg8_u2*)((unsigned char*)H + (size_t)(row0 + ai * HALF + m * 16) * ldh + col0) = (pg8_u2){(unsigned)p0, (unsigned)p1}; }
                else { u32x4 w; w.x = cvt_pk_bf16(h[0], h[1]); w.y = cvt_pk_bf16(h[2], h[3]); w.z = cvt_pk_bf16(h[4], h[5]); w.w = cvt_pk_bf16(h[6], h[7]);
                    *(u32x4*)rowp = w; } }
    }
};
struct EpiKV {
    static constexpr bool PERM = true, AFTER_DRAIN = false;
    bf16_t* KN; bf16_t* VT; int ldt;
    __device__ __forceinline__ void operator()(const f32x4 (&acc)[2][2][4][2], const Unit& u, int wr, int wc, int fr, int fq) const {
        const int row0 = u.pm * BM + wr * 64 + fr;
        if (u.pn < 2) {
            const int col0 = u.pn * BM + wc * 32 + 8 * fq;
#pragma unroll
            for (int ai = 0; ai < 2; ++ai)
#pragma unroll
                for (int m = 0; m < 4; ++m) { bf16_t* rowp = KN + (size_t)(row0 + ai * HALF + m * 16) * 512 + col0;
#pragma unroll
                    for (int bj = 0; bj < 2; ++bj) { const f32x4 v0 = acc[ai][bj][m][0], v1 = acc[ai][bj][m][1];
                        u32x4 w; w.x = cvt_pk_bf16(v0[0], v0[1]); w.y = cvt_pk_bf16(v0[2], v0[3]); w.z = cvt_pk_bf16(v1[0], v1[1]); w.w = cvt_pk_bf16(v1[2], v1[3]);
                        *(u32x4*)(rowp + bj * HALF) = w; } }
        } else {
            const int f0 = (u.pn - 2) * BM + wc * 32 + 8 * fq;
#pragma unroll
            for (int bj = 0; bj < 2; ++bj)
#pragma unroll
                for (int n = 0; n < 2; ++n)
#pragma unroll
                    for (int e = 0; e < 4; ++e) { bf16_t* cp = VT + (size_t)(f0 + bj * HALF + 4 * n + e) * ldt + row0;
#pragma unroll
                        for (int ai = 0; ai < 2; ++ai)
#pragma unroll
                            for (int m = 0; m < 4; ++m) cp[ai * HALF + m * 16] = (bf16_t)(cvt_pk_bf16(acc[ai][bj][m][n][e], 0.f) & 0xffffu);
                        asm volatile("" ::: "memory"); }
        }
    }
};

template <class Epi, class Sched, bool ALIGN_EPI = false, bool SP2 = false, int ES = 2>
__device__ __forceinline__ void gemm_phase(PG8_LAS unsigned char* lds, const Gemm g, const Sched& S, const Epi& E) {
    const int tid = mk_otid(), wid = __builtin_amdgcn_readfirstlane(tid >> 6), lane = tid & 63, wr = wid >> 2, wc = wid & 3, fr = lane & 15, fq = lane >> 4;
    const int K = g.K, nt = (K * ES) / (BK * 2), LD = g.ld ? g.ld : g.K;
    unsigned voffA[2], voffB[2];
#pragma unroll
    for (int i = 0; i < 2; ++i) { int R, C; stage_rc(tid * 16 + i * 8192, R, C); const int Rb = Epi::PERM ? ((R & ~31) + perm32(R & 31)) : R;
        voffA[i] = (unsigned)(R * LD * ES + C * 2); voffB[i] = (unsigned)(Rb * LD * ES + C * 2); }
    const size_t kstep = (size_t)(BK * 2);
    const size_t hstep = (size_t)HALF * LD * ES;
    const size_t tstep = 2 * hstep;
    const unsigned ldsw = (unsigned)wid * 1024u;
    const int aoff0 = ES == 2 ? lds_byte(wr * 64 + fr, fq * 8) : lds_byte(wr * 64 + fr, fq * 16), aoff1 = ES == 2 ? aoff0 + 1024 : lds_byte(wr * 64 + fr, fq * 16 + 8);
    const int boff0 = ES == 2 ? lds_byte(wc * 32 + fr, fq * 8) : lds_byte(wc * 32 + fr, fq * 16), boff1 = ES == 2 ? boff0 + 1024 : lds_byte(wc * 32 + fr, fq * 16 + 8);
#define PG8_SA(b, h) (((b) * 2 + (h)) * HTB)
#define PG8_SB(b, h) ((4 + (b) * 2 + (h)) * HTB)
#define PG8_STAGE(bufoff, gbase, voff) do { _Pragma("unroll") for (int _i = 0; _i < 2; ++_i) \
        __builtin_amdgcn_global_load_lds((const unsigned*)((const char*)(gbase) + (voff)[_i]), (PG8_LAS unsigned*)(lds + (bufoff) + ldsw + _i * 8192), 16, 0, 0); } while (0)
#define PG8_LD8(p0, p1) __builtin_shufflevector(*(const PG8_LAS pg8_v4i*)(p0), *(const PG8_LAS pg8_v4i*)(p1), 0, 1, 2, 3, 4, 5, 6, 7)
#define PG8_LDA(dst, b, h) do { if constexpr (ES == 2) { _Pragma("unroll") for (int m = 0; m < 4; ++m) _Pragma("unroll") for (int k = 0; k < 2; ++k) dst##2[m][k] = *(const PG8_LAS bf16x8*)(lds + PG8_SA(b, h) + (k ? aoff1 : aoff0) + m * 2048); } \
        else { _Pragma("unroll") for (int m = 0; m < 4; ++m) dst##8[m] = PG8_LD8(lds + PG8_SA(b, h) + aoff0 + m * 2048, lds + PG8_SA(b, h) + aoff1 + m * 2048); } } while (0)
#define PG8_LDB(dst, b, h) do { if constexpr (ES == 2) { _Pragma("unroll") for (int n = 0; n < 2; ++n) _Pragma("unroll") for (int k = 0; k < 2; ++k) dst##2[n][k] = *(const PG8_LAS bf16x8*)(lds + PG8_SB(b, h) + (k ? boff1 : boff0) + n * 2048); } \
        else { _Pragma("unroll") for (int n = 0; n < 2; ++n) dst##8[n] = PG8_LD8(lds + PG8_SB(b, h) + boff0 + n * 2048, lds + PG8_SB(b, h) + boff1 + n * 2048); } } while (0)
#define PG8_MMA(ai, bj, At, Bt) do { __builtin_amdgcn_s_setprio(1); _Pragma("unroll") for (int m = 0; m < 4; ++m) _Pragma("unroll") for (int n = 0; n < 2; ++n) { \
        if constexpr (ES == 2) { _Pragma("unroll") for (int k = 0; k < 2; ++k) acc[ai][bj][m][n] = __builtin_amdgcn_mfma_f32_16x16x32_bf16(Bt##2[n][k], At##2[m][k], acc[ai][bj][m][n], 0, 0, 0); } \
        else asm volatile("v_mfma_scale_f32_16x16x128_f8f6f4 %0, %1, %2, %0, %3, %4 op_sel_hi:[0,0,0]" : "+v"(acc[ai][bj][m][n]) : "v"(Bt##8[n]), "v"(At##8[m]), "v"(scw_), "v"(sca_)); } \
        __builtin_amdgcn_s_setprio(0); } while (0)
#define PG8_WAIT_V(n) asm volatile("s_waitcnt vmcnt(" #n ")" ::: "memory")
#define PG8_WAIT_L(n) asm volatile("s_waitcnt lgkmcnt(" #n ")" ::: "memory")
#define PG8_BAR __builtin_amdgcn_s_barrier()
#define PG8_SCHED __builtin_amdgcn_sched_barrier(0)
    Unit cur, nxt; int ui = 0;
    if (!S.next(0, cur)) return;
    f32x4 acc[2][2][4][2];
#pragma unroll
    for (int a = 0; a < 2; ++a)
#pragma unroll
        for (int b = 0; b < 2; ++b)
#pragma unroll
            for (int m = 0; m < 4; ++m)
#pragma unroll
                for (int n = 0; n < 2; ++n) acc[a][b][m][n] = (f32x4){0.f, 0.f, 0.f, 0.f};
    typedef int pg8_v4i __attribute__((ext_vector_type(4))); typedef int pg8_v8i __attribute__((ext_vector_type(8)));
    bf16x8 At2[4][2], B02[2][2], B12[2][2];
    pg8_v8i At8[4], B08[2], B18[2];
    const int scw_ = g.sb, sca_ = g.sa;
    const char* cA = (const char*)g.A + (size_t)cur.pm * tstep + cur.ko; const char* cB = (const char*)g.Bt + (size_t)cur.pn * tstep + cur.ko;
    S.a_ready(cur);
    if constexpr (SP2) {
        PG8_STAGE(PG8_SB(0, 0), cB, voffB); PG8_STAGE(PG8_SB(0, 1), cB + hstep, voffB); PG8_STAGE(PG8_SA(0, 0), cA, voffA); PG8_STAGE(PG8_SA(0, 1), cA + hstep, voffA);
        if (wr == 1) PG8_BAR;
        PG8_WAIT_V(2); PG8_BAR;
        PG8_STAGE(PG8_SB(1, 0), cB + kstep, voffB); PG8_STAGE(PG8_SA(1, 0), cA + kstep, voffA); PG8_STAGE(PG8_SB(1, 1), cB + hstep + kstep, voffB);
        PG8_WAIT_V(6); PG8_BAR;
    } else {
        PG8_STAGE(PG8_SB(0, 0), cB, voffB); PG8_STAGE(PG8_SA(0, 0), cA, voffA); PG8_STAGE(PG8_SB(0, 1), cB + hstep, voffB); PG8_STAGE(PG8_SA(0, 1), cA + hstep, voffA);
        if (wr == 1) PG8_BAR;
        PG8_WAIT_V(4); PG8_BAR;
        PG8_STAGE(PG8_SB(1, 0), cB + kstep, voffB); PG8_STAGE(PG8_SA(1, 0), cA + kstep, voffA); PG8_STAGE(PG8_SB(1, 1), cB + hstep + kstep, voffB);
        PG8_WAIT_V(6); PG8_BAR;
    }
    for (;;) {
        const bool has_next = S.next(ui + 1, nxt);
        const char* nA = has_next ? (const char*)g.A + (size_t)nxt.pm * tstep + nxt.ko : cA; const char* nB = has_next ? (const char*)g.Bt + (size_t)nxt.pn * tstep + nxt.ko : cB;
        for (int t = 0; t < nt; t += 2) {
            const bool last = (t == nt - 2);
            const char* a1 = cA + (size_t)(t + 1) * kstep;
            const char* a2 = last ? nA : cA + (size_t)(t + 2) * kstep; const char* b2 = last ? nB : cB + (size_t)(t + 2) * kstep;
            const char* a3 = a2 + kstep; const char* b3 = b2 + kstep;
            if (last && has_next) S.a_ready(nxt);
            if constexpr (SP2) {
            PG8_LDB(B0, 0, 0); PG8_LDB(B1, 0, 1); PG8_SCHED; PG8_LDA(At, 0, 0); PG8_STAGE(PG8_SA(1, 1), a1 + hstep, voffA);
            PG8_WAIT_V(8); PG8_WAIT_L(0); PG8_BAR; PG8_MMA(0, 0, At, B0); PG8_MMA(0, 1, At, B1); PG8_BAR; PG8_SCHED;
            PG8_LDA(At, 0, 1); PG8_STAGE(PG8_SB(0, 0), b2, voffB); PG8_STAGE(PG8_SB(0, 1), b2 + hstep, voffB); PG8_STAGE(PG8_SA(0, 0), a2, voffA);
            PG8_WAIT_V(8); PG8_WAIT_L(0); PG8_BAR; PG8_MMA(1, 0, At, B0); PG8_MMA(1, 1, At, B1); PG8_BAR; PG8_SCHED;
            PG8_LDB(B0, 1, 0); PG8_LDB(B1, 1, 1); PG8_SCHED; PG8_LDA(At, 1, 0); PG8_STAGE(PG8_SA(0, 1), a2 + hstep, voffA);
            PG8_WAIT_V(8); PG8_WAIT_L(0); PG8_BAR; PG8_MMA(0, 0, At, B0); PG8_MMA(0, 1, At, B1); PG8_BAR; PG8_SCHED;
            PG8_LDA(At, 1, 1); PG8_STAGE(PG8_SB(1, 0), b3, voffB); PG8_STAGE(PG8_SB(1, 1), b3 + hstep, voffB); PG8_STAGE(PG8_SA(1, 0), a3, voffA);
            PG8_WAIT_V(8); PG8_WAIT_L(0); PG8_BAR; PG8_MMA(1, 0, At, B0); PG8_MMA(1, 1, At, B1); PG8_BAR; PG8_SCHED;
            } else {
            PG8_LDB(B0, 0, 0); PG8_SCHED; PG8_LDA(At, 0, 0); PG8_STAGE(PG8_SA(1, 1), a1 + hstep, voffA);
            PG8_WAIT_L(8); PG8_BAR; PG8_WAIT_L(0); PG8_MMA(0, 0, At, B0); PG8_BAR; PG8_SCHED;
            PG8_LDB(B1, 0, 1); PG8_STAGE(PG8_SB(0, 0), b2, voffB);
            PG8_BAR; PG8_WAIT_L(0); PG8_MMA(0, 1, At, B1); PG8_BAR;
            PG8_LDA(At, 0, 1); PG8_STAGE(PG8_SA(0, 0), a2, voffA);
            PG8_BAR; PG8_WAIT_L(0); PG8_MMA(1, 0, At, B0); PG8_BAR; PG8_SCHED;
            PG8_STAGE(PG8_SB(0, 1), b2 + hstep, voffB);
            PG8_WAIT_V(6); PG8_BAR; PG8_MMA(1, 1, At, B1); PG8_BAR;
            PG8_LDB(B0, 1, 0); PG8_SCHED; PG8_LDA(At, 1, 0); PG8_STAGE(PG8_SA(0, 1), a2 + hstep, voffA);
            PG8_WAIT_L(8); PG8_BAR; PG8_WAIT_L(0); PG8_MMA(0, 0, At, B0); PG8_BAR; PG8_SCHED;
            PG8_LDB(B1, 1, 1); PG8_STAGE(PG8_SB(1, 0), b3, voffB);
            PG8_BAR; PG8_WAIT_L(0); PG8_MMA(0, 1, At, B1); PG8_BAR;
            PG8_LDA(At, 1, 1); PG8_STAGE(PG8_SA(1, 0), a3, voffA);
            PG8_BAR; PG8_WAIT_L(0); PG8_MMA(1, 0, At, B0); PG8_BAR; PG8_SCHED;
            PG8_STAGE(PG8_SB(1, 1), b3 + hstep, voffB);
            PG8_WAIT_V(6); PG8_BAR; PG8_MMA(1, 1, At, B1); PG8_BAR;
            }
        }
        if constexpr (ES == 1) asm volatile("s_nop 15\n\ts_nop 15" ::: "memory");
        if constexpr (ALIGN_EPI) { if (wr == 0) PG8_BAR; }
        if constexpr (!Epi::AFTER_DRAIN) { E(acc, cur, wr, wc, fr, fq); S.done(cur); }
        if (!has_next) break;
#pragma unroll
        for (int a = 0; a < 2; ++a)
#pragma unroll
            for (int b = 0; b < 2; ++b)
#pragma unroll
                for (int m = 0; m < 4; ++m)
#pragma unroll
                    for (int n = 0; n < 2; ++n) acc[a][b][m][n] = (f32x4){0.f, 0.f, 0.f, 0.f};
        cur = nxt; cA = nA; cB = nB; ++ui;
        if constexpr (ALIGN_EPI) { if (wr == 1) PG8_BAR; }
    }
    PG8_WAIT_V(0);
    if constexpr (!ALIGN_EPI) { if (wr == 0) PG8_BAR; }
    PG8_BAR;
    if constexpr (Epi::AFTER_DRAIN) { E.fused(acc, cur, wr, wc, fr, fq, lds, wid, lane); S.done(cur); }
#undef PG8_SA
#undef PG8_SB
#undef PG8_STAGE
#undef PG8_LDA
#undef PG8_LD8
#undef PG8_LDB
#undef PG8_MMA
#undef PG8_WAIT_V
#undef PG8_WAIT_L
#undef PG8_BAR
#undef PG8_SCHED
}
}

namespace mk {
typedef unsigned short bf16_t;
typedef short bf16x8 __attribute__((ext_vector_type(8)));
typedef float f32x4 __attribute__((ext_vector_type(4)));
typedef float f32x2 __attribute__((ext_vector_type(2)));
typedef float f32x16 __attribute__((ext_vector_type(16)));
typedef unsigned u32x4 __attribute__((ext_vector_type(4)));
typedef unsigned u32x2 __attribute__((ext_vector_type(2)));

constexpr int DM = 2048, NB = 2, SEQ = 4096, CTXL = 256, NLAT = NB * SEQ, NCTX = NB * CTXL, MROWS = NLAT + NCTX;
constexpr int DEPTH = 4, INW = 5168, INP = 5376, FFN = 5632, EXPD = 2816, NEXP = 8;
constexpr int OFF_AQ = 0, OFF_AK = 512, OFF_AV = 640, OFF_HY = 768, OFF_MQ = 2304, OFF_MK = 2816, OFF_MV = 3328, OFF_MO = 3840, OFF_MG = 4352, OFF_DQ = 4368, OFF_DKV = 4880, OFF_DKR = 5136;
constexpr int PT2_ROWS = 1664;
constexpr int MAXSLOT = 19456;
constexpr float EPS = 1e-6f, LOG2E = 1.4426950408889634f;
constexpr int NCHAIN = 16, NCHK = 34, CSTATE = 128 * 128 + 128;

constexpr size_t al256(size_t x) { return (x + 255) & ~(size_t)255; }
constexpr size_t WS_CTL = 0, CTL_BYTES = (size_t)2 << 20;
constexpr size_t WS_MOD = WS_CTL + CTL_BYTES;
constexpr size_t WS_ROPA = WS_MOD + al256((size_t)4 * 3 * 12288 * 4);
constexpr size_t WS_ROPM = WS_ROPA + al256((size_t)4096 * 32 * 8);
constexpr size_t WS_HDN = WS_ROPM + al256((size_t)4096 * 16 * 8);
constexpr size_t WS_FILT = WS_HDN + al256((size_t)4 * 4352 * 64 * 4);
constexpr size_t WS_FILTC = WS_FILT + al256((size_t)4 * 2 * 512 * 8192 * 2);
constexpr size_t WS_WIN = WS_FILTC + al256((size_t)4 * 2 * 512 * 512 * 4);
constexpr size_t WS_WOUT = WS_WIN + al256((size_t)4 * INP * DM * 2);
constexpr size_t WS_WGU = WS_WOUT + al256((size_t)4 * DM * DM * 2);
constexpr size_t WS_WDN = WS_WGU + al256((size_t)2 * 2 * FFN * DM * 2);
constexpr size_t WS_WGUE = WS_WDN + al256((size_t)2 * DM * FFN * 2);
constexpr size_t WS_WDNE = WS_WGUE + al256((size_t)2 * 8 * 2 * EXPD * DM * 2);
constexpr size_t WS_WUQ = WS_WDNE + al256((size_t)2 * 8 * DM * EXPD * 2);
constexpr size_t WS_WUKV = WS_WUQ + al256((size_t)4 * 768 * 512 * 2);
constexpr size_t WS_X = WS_WUKV + al256((size_t)4 * 1024 * 256 * 2);
constexpr size_t WS_HA = WS_X + al256((size_t)MROWS * DM * 4);
constexpr size_t WS_P = WS_HA + al256((size_t)MROWS * DM * 2);
constexpr size_t WS_PT2 = WS_P + al256((size_t)MROWS * INP * 2);
constexpr size_t WS_MIX = WS_PT2 + al256((size_t)PT2_ROWS * MROWS * 2);
constexpr size_t WS_Y = WS_MIX + al256((size_t)MROWS * DM * 2);
constexpr size_t WS_QN = WS_Y + al256((size_t)MROWS * DM * 2);
constexpr size_t WS_KVN = WS_QN + al256((size_t)MROWS * 512 * 2);
constexpr size_t WS_QU = WS_KVN + al256((size_t)MROWS * 256 * 2);
constexpr size_t WS_KN = WS_QU + al256((size_t)MROWS * 768 * 2);
constexpr size_t WS_VT = WS_KN + al256((size_t)MROWS * 512 * 2);
constexpr size_t WS_DC = WS_VT + al256((size_t)512 * MROWS * 2);
constexpr size_t WS_ML = WS_DC + al256((size_t)NCHAIN * NCHK * CSTATE * 4);
constexpr size_t WS_CIN = WS_ML + al256((size_t)NCHAIN * NCHK * 2 * 4);
constexpr size_t WS_NIN = WS_CIN + al256((size_t)NCHAIN * NCHK * 16384 * 2);
constexpr size_t WS_MIN = WS_NIN + al256((size_t)NCHAIN * NCHK * 128 * 4);
constexpr size_t WS_H = WS_MIN + al256((size_t)NCHAIN * NCHK * 4);
constexpr size_t WS_HG = WS_H + al256((size_t)MAXSLOT * EXPD * 2);
constexpr size_t WS_YS = WS_HG + al256((size_t)MAXSLOT * DM * 2);
constexpr size_t WS_ROUTE = WS_YS + al256((size_t)MAXSLOT * DM * 2);
constexpr size_t WS_HIST = WS_ROUTE + al256((size_t)MROWS * 16);
constexpr size_t WS_SLOT = WS_HIST + al256((size_t)256 * 8 * 4);
constexpr size_t WS_HT = WS_SLOT + al256((size_t)MROWS * 2 * 4);
constexpr size_t WS_FNORM = WS_HT + al256((size_t)512 * MROWS * 2);
constexpr size_t WS_YC = WS_FNORM + al256((size_t)2 * 4 * 2 * 512 * 4);
constexpr size_t WS_END = WS_YC + al256((size_t)11 * NCTX * DM * 2);
static_assert((size_t)MAXSLOT * EXPD >= (size_t)MROWS * FFN, "H buffer");

constexpr int LDS_BYTES = 163840, MISC_OFF = 159744;
constexpr int CW_BAR = 4096;

struct Args { const float* in[34]; float* out; unsigned char* ws; int ph_lo, ph_hi; };

DI float bf2f(unsigned v) { return __uint_as_float(v << 16); }
DI unsigned pk2(float lo, float hi) { return pg8::cvt_pk_bf16(lo, hi); }
DI bf16_t f2bf(float v) { return (bf16_t)(pk2(v, 0.f) & 0xffffu); }
DI float clamp8(float v) { return fminf(fmaxf(v, -448.0f), 448.0f); }
DI unsigned pk4_fp8(float a, float b, float c, float d) { int p = __builtin_amdgcn_cvt_pk_fp8_f32(clamp8(a), clamp8(b), 0, false); p = __builtin_amdgcn_cvt_pk_fp8_f32(clamp8(c), clamp8(d), p, true); return (unsigned)p; }
constexpr float W8_SCALE = 64.0f, H8_SCALE = 8.0f;
constexpr int SC_W8 = 0x79797979, SC_H8 = 0x7c7c7c7c, SC_ONE = 0x7f7f7f7f;
DI float wave_sum(float v) {
#pragma unroll
    for (int o = 1; o < 64; o <<= 1) v += mk_shx(v, o);
    return v;
}
DI int crow(int reg, int h) { return (reg & 3) + 8 * (reg >> 2) + 4 * h; }
DI float logsigmoid(float x) { return fminf(x, 0.f) - log1pf(expf(-fabsf(x))); }
#define MFMA32(a, b, c) __builtin_amdgcn_mfma_f32_32x32x16_bf16((a), (b), (c), 0, 0, 0)
DI f32x16 zero16() { f32x16 z;
#pragma unroll
    for (int i = 0; i < 16; ++i) z[i] = 0.f; return z; }
DI bf16x8 pack8(const f32x16& x, int s) {
    u32x4 p; p.x = pk2(x[8 * s + 0], x[8 * s + 1]); p.y = pk2(x[8 * s + 2], x[8 * s + 3]); p.z = pk2(x[8 * s + 4], x[8 * s + 5]); p.w = pk2(x[8 * s + 6], x[8 * s + 7]);
    return __builtin_bit_cast(bf16x8, p);
}
DI bf16x8 ld2x8(const bf16_t* p0, const bf16_t* p1) {
    unsigned a0 = (unsigned)(size_t)(const LAS bf16_t*)p0, a1 = (unsigned)(size_t)(const LAS bf16_t*)p1;
    asm volatile("" : "+v"(a1));
    const u32x2 a = *(const LAS u32x2*)(size_t)a0, b = *(const LAS u32x2*)(size_t)a1; u32x4 p; p.x = a.x; p.y = a.y; p.z = b.x; p.w = b.y; return __builtin_bit_cast(bf16x8, p);
}

#define XB_TMO      128
#define XB_XCNT(j)  (256  + 64 * (j))
#define XB_XSUB(j)  (1280 + 64 * (j))
#define XB_XGEN(j)  (2304 + 64 * (j))
#define XB_TOP      3328
#define XB_TOPGEN   3392
#define XCD_BAR_WORDS 3456
#define XB_SPIN_CAP (1u << 18)
DI unsigned xb_ld(unsigned* p)              { return __hip_atomic_load(p, __ATOMIC_RELAXED, __HIP_MEMORY_SCOPE_AGENT); }
DI unsigned xb_add(unsigned* p, unsigned v) { return __hip_atomic_fetch_add(p, v, __ATOMIC_RELAXED, __HIP_MEMORY_SCOPE_AGENT); }
DI unsigned xb_xcc_id() { return (unsigned)__builtin_amdgcn_s_getreg((3 << 11) | 20) & 0xFu; }
#define XB_SPIN(cond, bar) do { unsigned _sp = 0; while (cond) { __builtin_amdgcn_s_sleep(1); \
    if ((++_sp & 255u) == 0u) { if (xb_ld(&(bar)[XB_TMO])) break; if (_sp > XB_SPIN_CAP) { atomicAdd(&(bar)[XB_TMO], 1u); break; } } } } while (0)
struct XcdBarrier { unsigned* bar; unsigned x; volatile LAS unsigned* st; };
DI XcdBarrier xcd_barrier_post(unsigned* bar, volatile LAS unsigned* st) {
    XcdBarrier b; b.bar = bar; b.x = xb_xcc_id(); b.st = st;
    if (threadIdx.x == 0) (void)xb_add(&bar[XB_XCNT(b.x)], 1u);
    return b;
}
DI void xcd_barrier_complete(unsigned* bar, unsigned x, unsigned& nloc, unsigned& nx) {
    const unsigned G = gridDim.x * gridDim.y * gridDim.z;
    unsigned sum, cnt, mine, sp = 0u;
    for (;;) {
        sum = 0u; cnt = 0u; mine = 0u;
#pragma unroll
        for (unsigned j = 0; j < 16; ++j) { const unsigned c = xb_ld(&bar[XB_XCNT(j)]); sum += c; cnt += (c > 0u) ? 1u : 0u; mine = (j == x) ? c : mine; }
        if (sum == G) break;
        __builtin_amdgcn_s_sleep(1);
        if ((++sp & 255u) == 0u) { if (xb_ld(&bar[XB_TMO])) break; if (sp > XB_SPIN_CAP) { atomicAdd(&bar[XB_TMO], 1u); break; } }
    }
    nloc = mine > 0u ? mine : 1u; nx = cnt > 0u ? cnt : 1u;
}
DI void xcd_barrier(const XcdBarrier& b) {
    asm volatile("s_waitcnt vmcnt(0)" ::: "memory");
    __syncthreads();
    if (threadIdx.x == 0) {
        unsigned* bar = b.bar;
        __builtin_amdgcn_s_waitcnt(0);
        unsigned nloc = b.st[0], nx = b.st[1];
        if (nloc == 0u) { xcd_barrier_complete(bar, b.x, nloc, nx); b.st[0] = nloc; b.st[1] = nx; }
        const unsigned old = xb_add(&bar[XB_XSUB(b.x)], 1u);
        const unsigned gen = old / nloc;
        if (old + 1u == (gen + 1u) * nloc) {
            __builtin_amdgcn_fence(__ATOMIC_RELEASE, "agent");
            asm volatile("s_waitcnt vmcnt(0)" ::: "memory");
            const unsigned og = xb_add(&bar[XB_TOP], 1u);
            const unsigned tg = og / nx;
            if (og + 1u == (tg + 1u) * nx) xb_add(&bar[XB_TOPGEN], 1u);
            else XB_SPIN(xb_ld(&bar[XB_TOPGEN]) == tg, bar);
            __builtin_amdgcn_fence(__ATOMIC_ACQUIRE, "agent");
            xb_add(&bar[XB_XGEN(b.x)], 1u);
            asm volatile("s_waitcnt vmcnt(0)" ::: "memory");
        } else {
            XB_SPIN(xb_ld(&bar[XB_XGEN(b.x)]) == gen, bar);
            __builtin_amdgcn_fence(__ATOMIC_ACQUIRE, "agent");
            asm volatile("s_waitcnt vmcnt(0)" ::: "memory");
        }
    }
    __syncthreads();
}

DI void pro_mod_stage(const Args& a, unsigned char* lds) {
    const int tid = mk_otid();
    float* sv = (float*)lds;
    const float* c = a.in[1]; const float* cc = a.in[3];
    for (int i = tid; i < 3 * 2048; i += 512) { const int v = i >> 11, k = i & 2047; const float x = (v < 2) ? c[v * 2048 + k] : cc[k]; sv[i] = x / (1.0f + expf(-x)); }
    __syncthreads();
}
DI void pro_mod_units3(const Args& a, unsigned char* lds) {
    const int tid = mk_otid(), lane = tid & 63, wave = tid >> 6;
    const float* sv = (const float*)lds;
    float* red = (float*)(lds + 24576);
    const int bx = (int)blockIdx.x, pair = bx >> 3, layer = pair >> 3, strip = pair & 7, kc = bx & 7, k0 = kc * 256 + wave * 32;
    const float* W = a.in[4] + (size_t)layer * 2048 * 12288 + strip * 1536 + lane * 4 + (size_t)k0 * 12288;
    f32x4 acc[18];
#pragma unroll
    for (int i = 0; i < 18; ++i) acc[i] = (f32x4){0.f, 0.f, 0.f, 0.f};
#pragma unroll 4
    for (int k = 0; k < 32; ++k) { const float s0 = sv[k0 + k], s1 = sv[2048 + k0 + k], s2 = sv[4096 + k0 + k];
#pragma unroll
        for (int j = 0; j < 6; ++j) { const f32x4 w = __builtin_nontemporal_load((const f32x4*)(W + (size_t)k * 12288 + 256 * j));
            acc[3 * j] += w * s0; acc[3 * j + 1] += w * s1; acc[3 * j + 2] += w * s2; } }
    float* MODP = (float*)(a.ws + WS_P) + (size_t)kc * (4 * 3 * 12288);
#pragma unroll
    for (int half = 0; half < 2; ++half) {
#pragma unroll
        for (int i = 0; i < 9; ++i) *(f32x4*)(red + (wave * 9 + i) * 256 + lane * 4) = acc[9 * half + i];
        __syncthreads();
        for (int i = tid; i < 9 * 256; i += 512) { const int jv = i >> 8, j = 3 * half + jv / 3, v = jv % 3, col = i & 255;
            float s = kc == 0 ? a.in[5][layer * 12288 + strip * 1536 + 256 * j + col] : 0.f;
#pragma unroll
            for (int w = 0; w < 8; ++w) s += red[(w * 9 + jv) * 256 + col];
            MODP[(size_t)(layer * 3 + v) * 12288 + strip * 1536 + 256 * j + col] = s; }
        __syncthreads();
    }
}
DI void pro_mod_reduce(const Args& a) {
    const float* MODP = (const float*)(a.ws + WS_P); float* MOD = (float*)(a.ws + WS_MOD);
    for (int i = blockIdx.x * 512 + mk_otid(); i < 4 * 3 * 12288; i += gridDim.x * 512) { float s = MODP[i];
#pragma unroll
        for (int q = 1; q < 8; ++q) s += MODP[i + q * 147456];
        MOD[i] = s; }
}
DI int conv_dst_row(int mode, int n) {
    if (mode == 1) return (n >> 7) * 256 + (n & 127);
    if (mode == 2) return (n >> 7) * 256 + 128 + (n & 127);
    if (mode == 3) { const int hh = n >> 7, x = n & 127; return x < 64 ? hh * 64 + x : 512 + hh * 64 + (x - 64); }
    return n;
}
DI void conv_item(const float* W, int K, int N, int Nvalid, bf16_t* WT, int mode, int kb, int nb, float* scr  , int lane, float scale = 1.0f, int nsc = 0, bool f8 = false) {
    const int k0 = 64 * kb, n0 = 64 * nb, q = lane & 15, n = n0 + 4 * q;
    f32x4 v[16];
#pragma unroll
    for (int it = 0; it < 16; ++it) { const int kk = 4 * it + (lane >> 4); v[it] = (n < Nvalid) ? __builtin_nontemporal_load((const f32x4*)(W + (size_t)(k0 + kk) * N + n)) : (f32x4){0.f, 0.f, 0.f, 0.f}; }
#pragma unroll
    for (int it = 0; it < 16; ++it) { const int kk = 4 * it + (lane >> 4); float* d = scr + kk * 65 + 4 * q; d[0] = v[it][0]; d[1] = v[it][1]; d[2] = v[it][2]; d[3] = v[it][3]; }
    __builtin_amdgcn_s_waitcnt(0xc07f); __builtin_amdgcn_wave_barrier();
    const int c = lane & 7;
#pragma unroll
    for (int j = 0; j < 8; ++j) { const int nl = (lane >> 3) + 8 * j; const float* s = scr + (8 * c) * 65 + nl;
        const float sc = (n0 + nl) < nsc ? scale : 1.0f;
        if (f8) { u32x2 o8; o8.x = pk4_fp8(s[0 * 65] * sc, s[1 * 65] * sc, s[2 * 65] * sc, s[3 * 65] * sc); o8.y = pk4_fp8(s[4 * 65] * sc, s[5 * 65] * sc, s[6 * 65] * sc, s[7 * 65] * sc);
            __builtin_nontemporal_store(o8, (u32x2*)((unsigned char*)WT + (size_t)conv_dst_row(mode, n0 + nl) * K + k0 + 8 * c)); }
        else { u32x4 o; o.x = pk2(s[0 * 65] * sc, s[1 * 65] * sc); o.y = pk2(s[2 * 65] * sc, s[3 * 65] * sc); o.z = pk2(s[4 * 65] * sc, s[5 * 65] * sc); o.w = pk2(s[6 * 65] * sc, s[7 * 65] * sc);
            __builtin_nontemporal_store(o, (u32x4*)(WT + (size_t)conv_dst_row(mode, n0 + nl) * K + k0 + 8 * c)); } }
    __builtin_amdgcn_s_waitcnt(0xc07f); __builtin_amdgcn_wave_barrier();
}

DI void pro_convert(const Args& a, unsigned char* lds, int quarter) {
    const int tid = mk_otid(), lane = tid & 63, wave = __builtin_amdgcn_readfirstlane(tid >> 6);
    const int G = gridDim.x, gw = blockIdx.x * 8 + wave, NGW = G * 8;
    unsigned char* ws = a.ws;
        float* scr = (float*)(lds + wave * 16640);
        constexpr int I_IN = 32 * 84, I_OUT = 32 * 32, I_FG = 32 * 88, I_FD = 88 * 32, I_MG = 32 * 44, I_MD = 44 * 32, I_UQ = 8 * 12, I_UKV = 4 * 16;
        constexpr int T0 = 4 * I_IN, T1 = T0 + 4 * I_OUT, T2 = T1 + 2 * I_FG, T3 = T2 + 2 * I_FG, T4 = T3 + 2 * I_FD, T5 = T4 + 16 * I_MG, T6 = T5 + 16 * I_MG, T7 = T6 + 16 * I_MD, T8 = T7 + 4 * I_UQ, T9 = T8 + 4 * I_UKV;
        const int per = (T9 + 3) / 4, it_lo = quarter * per, it_hi = (it_lo + per < T9) ? it_lo + per : T9;
        for (int it = it_lo + gw; it < it_hi; it += NGW) {
            if (it < T0) { const int j = it / I_IN, r = it % I_IN; conv_item(a.in[10] + (size_t)j * DM * INW, DM, INW, INW, (bf16_t*)(ws + WS_WIN) + (size_t)j * INP * DM, 0, r / 84, r % 84, scr, lane, 0.125f * LOG2E, 512); }
            else if (it < T1) { const int q = it - T0, j = q / I_OUT, r = q % I_OUT; conv_item(a.in[11] + (size_t)j * DM * DM, DM, DM, DM, (bf16_t*)(ws + WS_WOUT) + (size_t)j * DM * DM, 0, r / 32, r % 32, scr, lane); }
            else if (it < T2) { const int q = it - T1, j = q / I_FG, r = q % I_FG; conv_item(a.in[27] + (size_t)j * DM * FFN, DM, FFN, FFN, (bf16_t*)(ws + WS_WGU + (size_t)j * 2 * FFN * DM), 1, 2 * ((r >> 1) / 88) + (r & 1), (r >> 1) % 88, scr, lane, W8_SCALE, 1 << 30, true); }
            else if (it < T3) { const int q = it - T2, j = q / I_FG, r = q % I_FG; conv_item(a.in[28] + (size_t)j * DM * FFN, DM, FFN, FFN, (bf16_t*)(ws + WS_WGU + (size_t)j * 2 * FFN * DM), 2, 2 * ((r >> 1) / 88) + (r & 1), (r >> 1) % 88, scr, lane, W8_SCALE, 1 << 30, true); }
            else if (it < T4) { const int q = it - T3, j = q / I_FD, r = q % I_FD; conv_item(a.in[29] + (size_t)j * FFN * DM, FFN, DM, DM, (bf16_t*)(ws + WS_WDN + (size_t)j * DM * FFN), 0, 2 * ((r >> 1) / 32) + (r & 1), (r >> 1) % 32, scr, lane, W8_SCALE, 1 << 30, true); }
            else if (it < T5) { const int q = it - T4, j = q / I_MG, r = q % I_MG; conv_item(a.in[31] + (size_t)j * DM * EXPD, DM, EXPD, EXPD, (bf16_t*)(ws + WS_WGUE + (size_t)j * 2 * EXPD * DM), 1, 2 * ((r >> 1) / 44) + (r & 1), (r >> 1) % 44, scr, lane, W8_SCALE, 1 << 30, true); }
            else if (it < T6) { const int q = it - T5, j = q / I_MG, r = q % I_MG; conv_item(a.in[32] + (size_t)j * DM * EXPD, DM, EXPD, EXPD, (bf16_t*)(ws + WS_WGUE + (size_t)j * 2 * EXPD * DM), 2, 2 * ((r >> 1) / 44) + (r & 1), (r >> 1) % 44, scr, lane, W8_SCALE, 1 << 30, true); }
            else if (it < T7) { const int q = it - T6, j = q / I_MD, r = q % I_MD; conv_item(a.in[33] + (size_t)j * EXPD * DM, EXPD, DM, DM, (bf16_t*)(ws + WS_WDNE + (size_t)j * DM * EXPD), 0, 2 * ((r >> 1) / 32) + (r & 1), (r >> 1) % 32, scr, lane, W8_SCALE, 1 << 30, true); }
            else if (it < T8) { const int q = it - T7, j = q / I_UQ, r = q % I_UQ; conv_item(a.in[24] + (size_t)j * 512 * 768, 512, 768, 768, (bf16_t*)(ws + WS_WUQ) + (size_t)j * 768 * 512, 0, r / 12, r % 12, scr, lane, 0.10206207261596577f * LOG2E, 768); }
            else { const int q = it - T8, j = q / I_UKV, r = q % I_UKV; conv_item(a.in[26] + (size_t)j * 256 * 1024, 256, 1024, 1024, (bf16_t*)(ws + WS_WUKV) + (size_t)j * 1024 * 256, 3, r / 16, r % 16, scr, lane); }
        }
}

DI void phase_pro_a(const Args& a, unsigned char* lds) {
    const int tid = mk_otid(), lane = tid & 63, wave = __builtin_amdgcn_readfirstlane(tid >> 6);
    const int G = gridDim.x, gw = blockIdx.x * 8 + wave, NGW = G * 8;
    unsigned char* ws = a.ws;
    pro_mod_stage(a, lds);
    pro_mod_units3(a, lds);
    {
        float* HDN = (float*)(ws + WS_HDN);
        const int layer = gw & 3;
        const float* w1 = a.in[14] + layer * 17 * 64; const float* w2 = a.in[16] + layer * 64 * 64; const float fr = a.in[18][layer * 64 + lane] * 0.15915494309189535f;
        const float b1 = a.in[15][layer * 64 + lane], b2 = a.in[17][layer * 64 + lane];
        float w1r[17], w2r[64];
#pragma unroll
        for (int k = 0; k < 17; ++k) w1r[k] = w1[k * 64 + lane];
#pragma unroll
        for (int k = 0; k < 64; ++k) w2r[k] = w2[k * 64 + lane];
        for (int it = gw; it < 4 * 4352; it += NGW) {
            const int p = it >> 2;
            const float tt = (p < 4096) ? (float)p / 4096.0f : (float)(p - 4096) / 256.0f;
            float pre = b1 + tt * w1r[0];
#pragma unroll
            for (int k = 1; k <= 8; ++k) { const float rev = tt * (float)k; pre += __builtin_amdgcn_sinf(rev) * w1r[k] + __builtin_amdgcn_cosf(rev) * w1r[8 + k]; }
            const float h1 = __builtin_amdgcn_sinf(__builtin_amdgcn_fractf(fr * pre));
            float pre2 = b2;
#pragma unroll
            for (int k = 0; k < 64; ++k) pre2 += __int_as_float(__builtin_amdgcn_readlane(__float_as_int(h1), k)) * w2r[k];
            HDN[((size_t)layer * 4352 + p) * 64 + lane] = __builtin_amdgcn_sinf(__builtin_amdgcn_fractf(fr * pre2));
        }
    }
    {
        f32x2* RA = (f32x2*)(ws + WS_ROPA); f32x2* RM = (f32x2*)(ws + WS_ROPM);
        const int gt = blockIdx.x * 512 + tid, NGT = G * 512;
        for (int i = gt; i < 4096 * 32; i += NGT) { const int pos = i >> 5, e = i & 31, part = e >> 4, k = e & 15; const float inv = powf(10000.0f, -(float)(2 * k) / 32.0f);
            const float ang = (float)(part ? (pos & 63) : (pos >> 6)) * inv; RA[i] = (f32x2){cosf(ang), sinf(ang)}; }
        for (int i = gt; i < 4096 * 16; i += NGT) { const int pos = i >> 4, e = i & 15, part = e >> 3, k = e & 7; const float inv = powf(10000.0f, -(float)(2 * k) / 16.0f);
            const float ang = (float)(part ? (pos & 63) : (pos >> 6)) * inv; RM[i] = (f32x2){cosf(ang), sinf(ang)}; }
    }
}

DI bf16x8 cvt8(const f32x4 a, const f32x4 b) { u32x4 p; p.x = pk2(a[0], a[1]); p.y = pk2(a[2], a[3]); p.z = pk2(b[0], b[1]); p.w = pk2(b[2], b[3]); return __builtin_bit_cast(bf16x8, p); }
template <int LL  >
DI void filt_tiles(const float* HDN  , const bf16x8 (&wf)[4], int c0, bf16_t* F16, float* F32, float (&s)[16], int wave, int r, int h) {
    constexpr int NT = LL / 32;
    f32x4 pa[8];
    if (wave < NT) { const float* hr = HDN + (size_t)(32 * wave + r) * 64 + 8 * h;
#pragma unroll
        for (int st = 0; st < 4; ++st) { pa[2 * st] = *(const f32x4*)(hr + 16 * st); pa[2 * st + 1] = *(const f32x4*)(hr + 16 * st + 4); } }
#pragma unroll 1
    for (int tile = wave; tile < NT; tile += 8) {
        const int t = 32 * tile + r;
        bf16x8 hf[4];
#pragma unroll
        for (int st = 0; st < 4; ++st) hf[st] = cvt8(pa[2 * st], pa[2 * st + 1]);
        if (tile + 8 < NT) { const float* hr = HDN + (size_t)(32 * (tile + 8) + r) * 64 + 8 * h;
#pragma unroll
            for (int st = 0; st < 4; ++st) { pa[2 * st] = *(const f32x4*)(hr + 16 * st); pa[2 * st + 1] = *(const f32x4*)(hr + 16 * st + 4); } }
        f32x16 acc = zero16();
#pragma unroll
        for (int st = 0; st < 4; ++st) acc = MFMA32(wf[st], hf[st], acc);
        const float tf = (float)t / (float)LL;
#pragma unroll
        for (int reg = 0; reg < 16; ++reg) { const int o = reg >> 3, dir = (reg >> 2) & 1, cc = (reg & 3) + 4 * h;
            const float delta = 3.0701134573253945f + (15.350567286626973f - 3.0701134573253945f) * (float)(c0 + cc) / 511.0f;
            float g = acc[reg] * expf(-tf * delta);
            if (dir == 0 || t > 0) s[reg] += fabsf(g);
            int m = dir == 0 ? LL - t : LL + t; if (dir == 1 && t == 0) { m = 0; g = 0.f; }
            if (LL == 4096) F16[((size_t)o * 512 + c0 + cc) * (2 * LL) + m] = f2bf(g); else F32[((size_t)o * 512 + c0 + cc) * (2 * LL) + m] = g; }
    }
}
DI void phase_pro_b(const Args& a, unsigned char* lds) {
    const int tid = mk_otid(), lane = tid & 63, wave = __builtin_amdgcn_readfirstlane(tid >> 6), r = lane & 31, h = lane >> 5;
    pro_mod_reduce(a);
    float* red = (float*)lds;
    const int fq = blockIdx.x & 3;
#pragma unroll 1
    for (int quarter = 0; quarter < 4; ++quarter) {
    pro_convert(a, lds, quarter);
    if (quarter != fq) continue;
    __syncthreads();
    for (int u = blockIdx.x; u < 256; u += gridDim.x) {
        const int layer = u >> 6, cg = u & 63, c0 = cg * 8;
        const float* w3 = a.in[19] + (size_t)layer * 64 * 2048;
        bf16x8 wf[4];
        { const int q = r, col = ((q >> 4) * 2 + ((q >> 3) & 1)) * 512 + c0 + (q & 7);
#pragma unroll
          for (int st = 0; st < 4; ++st) { float v[8];
#pragma unroll
              for (int j = 0; j < 8; ++j) v[j] = w3[(size_t)(16 * st + 8 * h + j) * 2048 + col];
              wf[st] = cvt8((f32x4){v[0], v[1], v[2], v[3]}, (f32x4){v[4], v[5], v[6], v[7]}); } }
#pragma unroll 1
        for (int which = 0; which < 2; ++which) {
            const float* HDN = (const float*)(a.ws + WS_HDN) + ((size_t)layer * 4352 + (which ? 4096 : 0)) * 64;
            float s[16];
#pragma unroll
            for (int i = 0; i < 16; ++i) s[i] = 0.f;
            if (which == 0) filt_tiles<4096>(HDN, wf, c0, (bf16_t*)(a.ws + WS_FILT) + (size_t)layer * 2 * 512 * 8192, nullptr, s, wave, r, h);
            else filt_tiles<256>(HDN, wf, c0, nullptr, (float*)(a.ws + WS_FILTC) + (size_t)layer * 2 * 512 * 512, s, wave, r, h);
#pragma unroll
            for (int reg = 0; reg < 16; ++reg) { float v = s[reg];
#pragma unroll
                for (int o2 = 1; o2 < 32; o2 <<= 1) v += mk_shx(v, o2);
                if (r == 0) red[wave * 32 + crow(reg, h)] = v; }
            __syncthreads();
            if (tid < 16) { const int o = tid >> 3, cc = tid & 7; float t = 0.f; for (int w = 0; w < 8; ++w) t += red[w * 32 + o * 16 + cc] + red[w * 32 + o * 16 + 8 + cc];
                ((float*)(a.ws + WS_FNORM))[((which * 4 + layer) * 2 + o) * 512 + c0 + cc] = t; }
            __syncthreads();
        }
    }
    __syncthreads();
    }
}

struct NormP {
    const float* xin_lat; const float* xin_ctx; float* xout_lat; float* xout_ctx; int nrows;
    int xin_b16, xout_b16;
    const bf16_t* ysrc; const int* slot; const f32x4* route;
    const float* mod_gate; const float* gpost;
    const float* mod_shift; const float* mod_scale; const float* gpre; bf16_t* ha;
    const float* router; f32x4* route_out; int* hist_out;
    int ha8;
    const bf16_t* yctx; int nsc;
};
struct NormRow { f32x4 x[8]; u32x2 xb[8]; u32x2 y0[8]; u32x2 y1[8]; f32x4 rt; };
template <bool RES, bool MOE, bool XB>
DI void norm_load(const NormP& p, int row, int lane, NormRow& R) {
    if (XB) { const bf16_t* xr = row < NLAT ? (const bf16_t*)p.xin_lat + (size_t)row * DM : (const bf16_t*)p.xin_ctx + (size_t)(row - NLAT) * DM;
#pragma unroll
        for (int j = 0; j < 8; ++j) R.xb[j] = *(const u32x2*)(xr + 256 * j + 4 * lane); }
    else { const float* xr = row < NLAT ? p.xin_lat + (size_t)row * DM : p.xin_ctx + (size_t)(row - NLAT) * DM;
#pragma unroll
        for (int j = 0; j < 8; ++j) R.x[j] = *(const f32x4*)(xr + 256 * j + 4 * lane); }
    if (RES) {
        if (MOE) { const int p0 = p.slot[row * 2], p1 = p.slot[row * 2 + 1]; R.rt = p.route[row];
            const bf16_t* y0 = p.ysrc + (size_t)p0 * DM, *y1 = p.ysrc + (size_t)p1 * DM;
#pragma unroll
            for (int j = 0; j < 8; ++j) { R.y0[j] = *(const u32x2*)(y0 + 256 * j + 4 * lane); R.y1[j] = *(const u32x2*)(y1 + 256 * j + 4 * lane); }
        } else if (!(p.yctx && row >= NLAT)) { const bf16_t* y0 = p.ysrc + (size_t)row * DM;
#pragma unroll
            for (int j = 0; j < 8; ++j) R.y0[j] = *(const u32x2*)(y0 + 256 * j + 4 * lane); }
    }
}
template <bool RES, bool MOE, bool HAOUT, bool ROUTER, bool XB = true>
DI void norm_phase(const NormP& p, unsigned char* lds) {
    const int tid = mk_otid(), lane = tid & 63, wave = tid >> 6;
    float* L = (float*)lds;
    float* Lgate = L, *Lshift = L + 6144, *Lscale = L + 12288, *Lgpost = L + 18432, *Lgpre = L + 20480, *Lrouter = L + 22528;
    int* hist = (int*)(lds + 155648);
    const int G = gridDim.x, nl = NLAT / G, nc = p.nrows > NLAT ? NCTX / G : 0, nr = nl + nc, bx = blockIdx.x;
#define NROW(i) ((i) < nl ? bx * nl + (i) : NLAT + bx * nc + ((i) - nl))
    NormRow R;
    if (wave < nr) norm_load<RES, MOE, XB>(p, NROW(wave), lane, R);
    {
        f32x4 sg[3], ssh[3], ssc[3]; const int d = 4 * tid;
#pragma unroll
        for (int v = 0; v < 3; ++v) { if (RES) sg[v] = *(const f32x4*)(p.mod_gate + v * 12288 + d); if (HAOUT) { ssh[v] = *(const f32x4*)(p.mod_shift + v * 12288 + d); ssc[v] = *(const f32x4*)(p.mod_scale + v * 12288 + d); } }
#pragma unroll
        for (int v = 0; v < 3; ++v) { if (RES) *(f32x4*)(Lgate + v * 2048 + d) = sg[v]; if (HAOUT) { *(f32x4*)(Lshift + v * 2048 + d) = ssh[v]; *(f32x4*)(Lscale + v * 2048 + d) = ssc[v]; } } }
    { const int d = 4 * tid; if (RES) *(f32x4*)(Lgpost + d) = *(const f32x4*)(p.gpost + d); if (HAOUT) *(f32x4*)(Lgpre + d) = *(const f32x4*)(p.gpre + d); }
    if (ROUTER) {
        f32x4 rq[4][2];
#pragma unroll
        for (int it = 0; it < 4; ++it) { const int k = tid + 512 * it; rq[it][0] = *(const f32x4*)(p.router + 8 * k); rq[it][1] = *(const f32x4*)(p.router + 8 * k + 4); }
#pragma unroll
        for (int it = 0; it < 4; ++it) { const int k = tid + 512 * it; const f32x4 ra = rq[it][0], rb = rq[it][1];
            Lrouter[k] = ra[0]; Lrouter[2048 + k] = ra[1]; Lrouter[4096 + k] = ra[2]; Lrouter[6144 + k] = ra[3]; Lrouter[8192 + k] = rb[0]; Lrouter[10240 + k] = rb[1]; Lrouter[12288 + k] = rb[2]; Lrouter[14336 + k] = rb[3]; }
        if (tid < 8) hist[tid] = 0; }
    __syncthreads();
#pragma unroll 1
    for (int ri = wave; ri < nr; ri += 8) { const int row = NROW(ri);
        const int v = row < NLAT ? (row >> 12) : 2;
        f32x4 x[8], y[8];
#pragma unroll
        for (int j = 0; j < 8; ++j) { if (XB) { const u32x2 a = R.xb[j]; x[j] = (f32x4){bf2f(a.x & 0xffffu), bf2f(a.x >> 16), bf2f(a.y & 0xffffu), bf2f(a.y >> 16)}; } else x[j] = R.x[j]; }
        if (RES) {
            if (MOE) {
#pragma unroll
                for (int j = 0; j < 8; ++j) { const u32x2 a = R.y0[j], b = R.y1[j]; const f32x4 rt = R.rt;
                    y[j][0] = rt[2] * bf2f(a.x & 0xffffu) + rt[3] * bf2f(b.x & 0xffffu); y[j][1] = rt[2] * bf2f(a.x >> 16) + rt[3] * bf2f(b.x >> 16);
                    y[j][2] = rt[2] * bf2f(a.y & 0xffffu) + rt[3] * bf2f(b.y & 0xffffu); y[j][3] = rt[2] * bf2f(a.y >> 16) + rt[3] * bf2f(b.y >> 16); }
            } else if (p.yctx && row >= NLAT) {
#pragma unroll
                for (int j = 0; j < 8; ++j) y[j] = (f32x4){0.f, 0.f, 0.f, 0.f};
#pragma unroll 1
                for (int s0 = 0; s0 < p.nsc; s0 += 4) { u32x2 tq[4][8];
#pragma unroll
                    for (int i = 0; i < 4; ++i) { const int s = s0 + i < p.nsc ? s0 + i : p.nsc - 1; const bf16_t* ys = p.yctx + ((size_t)s * NCTX + (row - NLAT)) * DM;
#pragma unroll
                        for (int j = 0; j < 8; ++j) tq[i][j] = *(const u32x2*)(ys + 256 * j + 4 * lane); }
#pragma unroll
                    for (int i = 0; i < 4; ++i) { const float wgt = s0 + i < p.nsc ? 1.0f : 0.0f;
#pragma unroll
                        for (int j = 0; j < 8; ++j) { const u32x2 a = tq[i][j];
                            y[j][0] += wgt * bf2f(a.x & 0xffffu); y[j][1] += wgt * bf2f(a.x >> 16); y[j][2] += wgt * bf2f(a.y & 0xffffu); y[j][3] += wgt * bf2f(a.y >> 16); } } }
            } else {
#pragma unroll
                for (int j = 0; j < 8; ++j) { const u32x2 a = R.y0[j];
                    y[j][0] = bf2f(a.x & 0xffffu); y[j][1] = bf2f(a.x >> 16); y[j][2] = bf2f(a.y & 0xffffu); y[j][3] = bf2f(a.y >> 16); }
            }
        }
        if (ri + 8 < nr) norm_load<RES, MOE, XB>(p, NROW(ri + 8), lane, R);
        if (RES) {
            float ss = 0.f;
#pragma unroll
            for (int j = 0; j < 8; ++j) ss += (y[j][0] * y[j][0] + y[j][1] * y[j][1]) + (y[j][2] * y[j][2] + y[j][3] * y[j][3]);
            const float r = rsqrtf(wave_sum(ss) * (1.0f / DM) + EPS);
            float* xo = p.xout_b16 ? (float*)(row < NLAT ? (bf16_t*)p.xout_lat + (size_t)row * DM : (bf16_t*)p.xout_ctx + (size_t)(row - NLAT) * DM) : (row < NLAT ? p.xout_lat + (size_t)row * DM : p.xout_ctx + (size_t)(row - NLAT) * DM);
#pragma unroll
            for (int j = 0; j < 8; ++j) { const f32x4 g = *(const f32x4*)(Lgate + v * 2048 + 256 * j + 4 * lane), gp = *(const f32x4*)(Lgpost + 256 * j + 4 * lane);
                x[j] += g * (y[j] * r * gp);
                if (p.xout_b16) { u32x2 w; w.x = pk2(x[j][0], x[j][1]); w.y = pk2(x[j][2], x[j][3]); *(u32x2*)((bf16_t*)xo + 256 * j + 4 * lane) = w; } else *(f32x4*)(xo + 256 * j + 4 * lane) = x[j]; }
        }
        if (HAOUT) {
            float ss = 0.f;
#pragma unroll
            for (int j = 0; j < 8; ++j) ss += (x[j][0] * x[j][0] + x[j][1] * x[j][1]) + (x[j][2] * x[j][2] + x[j][3] * x[j][3]);
            const float r = rsqrtf(wave_sum(ss) * (1.0f / DM) + EPS);
            float lg[8];
#pragma unroll
            for (int e = 0; e < 8; ++e) lg[e] = 0.f;
            bf16_t* ho = p.ha + (size_t)row * DM;
#pragma unroll
            for (int j = 0; j < 8; ++j) { const f32x4 gp = *(const f32x4*)(Lgpre + 256 * j + 4 * lane), sh = *(const f32x4*)(Lshift + v * 2048 + 256 * j + 4 * lane), sc = *(const f32x4*)(Lscale + v * 2048 + 256 * j + 4 * lane);
                const f32x4 h = (x[j] * r * gp) * (sc + 1.0f) + sh;
                if (p.ha8) *(unsigned*)((unsigned char*)p.ha + (size_t)row * DM + 256 * j + 4 * lane) = pk4_fp8(h[0] * H8_SCALE, h[1] * H8_SCALE, h[2] * H8_SCALE, h[3] * H8_SCALE);
                else { u32x2 w; w.x = pk2(h[0], h[1]); w.y = pk2(h[2], h[3]); *(u32x2*)(ho + 256 * j + 4 * lane) = w; }
                if (ROUTER) {
#pragma unroll
                    for (int e = 0; e < 8; ++e) { const f32x4 rr = *(const f32x4*)(Lrouter + e * 2048 + 256 * j + 4 * lane);
                        lg[e] += (h[0] * rr[0] + h[1] * rr[1]) + (h[2] * rr[2] + h[3] * rr[3]); } } }
            if (ROUTER) {
#pragma unroll
                for (int e = 0; e < 8; ++e) lg[e] = wave_sum(lg[e]);
                int i0 = 0; float v0 = lg[0];
#pragma unroll
                for (int e = 1; e < 8; ++e) if (lg[e] > v0) { v0 = lg[e]; i0 = e; }
                int i1 = -1; float v1 = -3.0e38f;
#pragma unroll
                for (int e = 0; e < 8; ++e) if (e != i0 && lg[e] > v1) { v1 = lg[e]; i1 = e; }
                const float w0 = 1.0f / (1.0f + expf(v1 - v0)), w1 = 1.0f - w0;
                if (lane == 0) { p.route_out[row] = (f32x4){__int_as_float(i0), __int_as_float(i1), w0, w1}; atomicAdd(&hist[i0], 1); atomicAdd(&hist[i1], 1); }
            }
        }
    }
    if (ROUTER) { __syncthreads(); if (tid < 8) p.hist_out[blockIdx.x * 8 + tid] = hist[tid]; }
    __syncthreads();
#undef NROW
}

DI void phase_gather(const Args& a, int nrows, unsigned char* lds) {
    const int tid = mk_otid(), lane = tid & 63, wave = tid >> 6, G = gridDim.x;
    int* base = (int*)lds; int* tot = base + 8; int* pos = base + 32;
    const int* HIST = (const int*)(a.ws + WS_HIST); const f32x4* ROUTE = (const f32x4*)(a.ws + WS_ROUTE); int* SLOT = (int*)(a.ws + WS_SLOT);
    if (tid < 16) base[tid] = 0;
    __syncthreads();
    { const int e = tid & 7; int b = 0, t = 0; for (int w = tid >> 3; w < G; w += 64) { const int hc = HIST[w * 8 + e]; if (w < (int)blockIdx.x) b += hc; t += hc; }
      __hip_atomic_fetch_add(&base[e], b, __ATOMIC_RELAXED, __HIP_MEMORY_SCOPE_WORKGROUP); __hip_atomic_fetch_add(&tot[e], t, __ATOMIC_RELAXED, __HIP_MEMORY_SCOPE_WORKGROUP); }
    __syncthreads();
    const int nl = NLAT / G, nc = nrows > NLAT ? NCTX / G : 0, nr = nl + nc, bx = blockIdx.x;
#define NROW(i) ((i) < nl ? bx * nl + (i) : NLAT + bx * nc + ((i) - nl))
    if (wave == 0) {
        int seg[8]; int s = 0;
#pragma unroll
        for (int e = 0; e < 8; ++e) { seg[e] = s + base[e]; s += (tot[e] + 255) & ~255; }
        for (int r0 = 0; r0 < nr; r0 += 64) { const int ri = r0 + lane; const bool act = ri < nr; const int row = NROW(act ? ri : 0);
            const f32x4 rt = ROUTE[row]; const int e0 = act ? __float_as_int(rt[0]) : -1, e1 = act ? __float_as_int(rt[1]) : -1;
            int p0 = 0, p1 = 0;
#pragma unroll
            for (int e = 0; e < 8; ++e) { const unsigned long long m0 = __ballot(e0 == e), m1 = __ballot(e1 == e);
                const int c0 = (int)__builtin_amdgcn_mbcnt_hi((unsigned)(m0 >> 32), __builtin_amdgcn_mbcnt_lo((unsigned)m0, 0u)) + (int)__builtin_amdgcn_mbcnt_hi((unsigned)(m1 >> 32), __builtin_amdgcn_mbcnt_lo((unsigned)m1, 0u));
                if (e0 == e) p0 = seg[e] + c0; if (e1 == e) p1 = seg[e] + c0;
                seg[e] += __popcll(m0) + __popcll(m1); }
            if (act) { pos[2 * ri] = p0; pos[2 * ri + 1] = p1; SLOT[row * 2] = p0; SLOT[row * 2 + 1] = p1; } }
    }
    __syncthreads();
    const bf16_t* HA = (const bf16_t*)(a.ws + WS_HA); bf16_t* HG = (bf16_t*)(a.ws + WS_HG);
    for (int q0 = wave; q0 < 2 * nr; q0 += 72) { u32x4 g0[9], g1[9];
#pragma unroll
        for (int i = 0; i < 9; ++i) { const int q = q0 + 8 * i; if (q < 2 * nr) { const u32x4* src = (const u32x4*)((const unsigned char*)HA + (size_t)NROW(q >> 1) * DM); g0[i] = src[lane]; g1[i] = src[lane + 64]; } }
#pragma unroll
        for (int i = 0; i < 9; ++i) { const int q = q0 + 8 * i; if (q < 2 * nr) { u32x4* dst = (u32x4*)((unsigned char*)HG + (size_t)pos[q] * DM); dst[lane] = g0[i]; dst[lane + 64] = g1[i]; } } }
    __syncthreads();
#undef NROW
}
DI void moe_tiles(const Args& a, unsigned char* lds, pg8::GroupedOrder& S) {
    const int tid = mk_otid(), G = gridDim.x; int* tot = (int*)(lds + MISC_OFF + 64);
    const int* HIST = (const int*)(a.ws + WS_HIST);
    if (tid < 8) tot[tid] = 0;
    __syncthreads();
    { const int e = tid & 7; int t = 0; for (int w = tid >> 3; w < G; w += 64) t += HIST[w * 8 + e]; __hip_atomic_fetch_add(&tot[e], t, __ATOMIC_RELAXED, __HIP_MEMORY_SCOPE_WORKGROUP); }
    __syncthreads();
    int s = 0, st[9];
#pragma unroll
    for (int e = 0; e < 8; ++e) { st[e] = s; s += (tot[e] + 255) >> 8; }
    st[8] = s;
    S.s1 = __builtin_amdgcn_readfirstlane(st[1]); S.s2 = __builtin_amdgcn_readfirstlane(st[2]); S.s3 = __builtin_amdgcn_readfirstlane(st[3]); S.s4 = __builtin_amdgcn_readfirstlane(st[4]);
    S.s5 = __builtin_amdgcn_readfirstlane(st[5]); S.s6 = __builtin_amdgcn_readfirstlane(st[6]); S.s7 = __builtin_amdgcn_readfirstlane(st[7]); S.nM = __builtin_amdgcn_readfirstlane(st[8]);
    __syncthreads();
}

DI void task_rope(const Args& a, int vb = -1, int vg = 0) {
    bf16_t* P = (bf16_t*)(a.ws + WS_P); const f32x2* RA = (const f32x2*)(a.ws + WS_ROPA); const f32x2* RM = (const f32x2*)(a.ws + WS_ROPM);
    const int gt = (vb >= 0 ? vb : (int)blockIdx.x) * 512 + mk_otid(), NGT = (vb >= 0 ? vg : (int)gridDim.x) * 512;
    for (int i0 = gt; i0 < NLAT * 40; i0 += 3 * NGT) {
        u32x4 x1v[3], x2v[3]; bf16_t* bp[3];
#pragma unroll
        for (int k3 = 0; k3 < 3; ++k3) { const int i = i0 + k3 * NGT, ic = i < NLAT * 40 ? i : gt; const int row = ic / 40, r = ic % 40, hs = r >> 2, part = (r >> 1) & 1, i8 = (r & 1) * 8;
            bp[k3] = P + (size_t)row * INP + (hs < 8 ? 64 * hs : OFF_AK + 64 * (hs - 8)) + part * 32 + i8; x1v[k3] = *(const u32x4*)bp[k3]; x2v[k3] = *(const u32x4*)(bp[k3] + 16); }
#pragma unroll
        for (int k3 = 0; k3 < 3; ++k3) { const int i = i0 + k3 * NGT; if (i >= NLAT * 40) break;
            const int row = i / 40, r = i % 40, part = (r >> 1) & 1, i8 = (r & 1) * 8, pos = row & 4095;
            bf16_t* b = bp[k3]; const u32x4 x1 = x1v[k3], x2 = x2v[k3]; u32x4 o1, o2;
#pragma unroll
            for (int w = 0; w < 4; ++w) {
                const f32x2 cs0 = RA[pos * 32 + part * 16 + i8 + 2 * w], cs1 = RA[pos * 32 + part * 16 + i8 + 2 * w + 1];
                const float a0 = bf2f(x1[w] & 0xffffu), a1 = bf2f(x1[w] >> 16), b0 = bf2f(x2[w] & 0xffffu), b1 = bf2f(x2[w] >> 16);
                o1[w] = pk2(a0 * cs0.x - b0 * cs0.y, a1 * cs1.x - b1 * cs1.y); o2[w] = pk2(b0 * cs0.x + a0 * cs0.y, b1 * cs1.x + a1 * cs1.y); }
            *(u32x4*)b = o1; *(u32x4*)(b + 16) = o2; }
    }
    for (int i = gt; i < NLAT * 2; i += NGT) {
        const int row = i >> 1, part = i & 1, pos = row & 4095;
        bf16_t* b = P + (size_t)row * INP + OFF_DKR + part * 16;
        const u32x4 x1 = *(const u32x4*)b, x2 = *(const u32x4*)(b + 8); u32x4 o1, o2;
#pragma unroll
        for (int w = 0; w < 4; ++w) {
            const f32x2 cs0 = RM[pos * 16 + part * 8 + 2 * w], cs1 = RM[pos * 16 + part * 8 + 2 * w + 1];
            const float a0 = bf2f(x1[w] & 0xffffu), a1 = bf2f(x1[w] >> 16), b0 = bf2f(x2[w] & 0xffffu), b1 = bf2f(x2[w] >> 16);
            o1[w] = pk2(a0 * cs0.x - b0 * cs0.y, a1 * cs1.x - b1 * cs1.y); o2[w] = pk2(b0 * cs0.x + a0 * cs0.y, b1 * cs1.x + a1 * cs1.y); }
        *(u32x4*)b = o1; *(u32x4*)(b + 8) = o2;
    }
}
DI void task_mla_norm(const Args& a, int layer, int vb = -1, int vg = 0) {
    const int lane = mk_otid() & 63, gw = (vb >= 0 ? vb : (int)blockIdx.x) * 8 + (mk_otid() >> 6), NGW = (vb >= 0 ? vg : (int)gridDim.x) * 8;
    const bf16_t* P = (const bf16_t*)(a.ws + WS_P); bf16_t* QN = (bf16_t*)(a.ws + WS_QN); bf16_t* KVN = (bf16_t*)(a.ws + WS_KVN);
    const float* qn = a.in[23] + layer * 512 + 8 * lane; const float* kn = a.in[25] + layer * 256 + 4 * lane;
    u32x4 qv[5]; u32x2 kv[5];
#pragma unroll
    for (int k5 = 0; k5 < 5; ++k5) { const int row = gw + k5 * NGW; if (row < MROWS) { qv[k5] = *(const u32x4*)(P + (size_t)row * INP + OFF_DQ + 8 * lane); kv[k5] = *(const u32x2*)(P + (size_t)row * INP + OFF_DKV + 4 * lane); } }
#pragma unroll
    for (int k5 = 0; k5 < 5; ++k5) { const int row = gw + k5 * NGW; if (row >= MROWS) break;
        const u32x4 q = qv[k5];
        float f[8]; float ss = 0.f;
#pragma unroll
        for (int w = 0; w < 4; ++w) { f[2 * w] = bf2f(q[w] & 0xffffu); f[2 * w + 1] = bf2f(q[w] >> 16); ss += f[2 * w] * f[2 * w] + f[2 * w + 1] * f[2 * w + 1]; }
        const float r = rsqrtf(wave_sum(ss) * (1.0f / 512.0f) + EPS);
        u32x4 o;
#pragma unroll
        for (int w = 0; w < 4; ++w) o[w] = pk2(f[2 * w] * r * qn[2 * w], f[2 * w + 1] * r * qn[2 * w + 1]);
        *(u32x4*)(QN + (size_t)row * 512 + 8 * lane) = o;
        const u32x2 k = kv[k5];
        const float g0 = bf2f(k.x & 0xffffu), g1 = bf2f(k.x >> 16), g2 = bf2f(k.y & 0xffffu), g3 = bf2f(k.y >> 16);
        const float r2 = rsqrtf(wave_sum(g0 * g0 + g1 * g1 + g2 * g2 + g3 * g3) * (1.0f / 256.0f) + EPS);
        u32x2 o2; o2.x = pk2(g0 * r2 * kn[0], g1 * r2 * kn[1]); o2.y = pk2(g2 * r2 * kn[2], g3 * r2 * kn[3]);
        *(u32x2*)(KVN + (size_t)row * 256 + 4 * lane) = o2;
    }
    if (NGW * 5 < MROWS) for (int row = gw + 5 * NGW; row < MROWS; row += NGW) {
        const u32x4 q = *(const u32x4*)(P + (size_t)row * INP + OFF_DQ + 8 * lane);
        float f[8]; float ss = 0.f;
#pragma unroll
        for (int w = 0; w < 4; ++w) { f[2 * w] = bf2f(q[w] & 0xffffu); f[2 * w + 1] = bf2f(q[w] >> 16); ss += f[2 * w] * f[2 * w] + f[2 * w + 1] * f[2 * w + 1]; }
        const float r = rsqrtf(wave_sum(ss) * (1.0f / 512.0f) + EPS);
        u32x4 o;
#pragma unroll
        for (int w = 0; w < 4; ++w) o[w] = pk2(f[2 * w] * r * qn[2 * w], f[2 * w + 1] * r * qn[2 * w + 1]);
        *(u32x4*)(QN + (size_t)row * 512 + 8 * lane) = o;
        const u32x2 k = *(const u32x2*)(P + (size_t)row * INP + OFF_DKV + 4 * lane);
        const float g0 = bf2f(k.x & 0xffffu), g1 = bf2f(k.x >> 16), g2 = bf2f(k.y & 0xffffu), g3 = bf2f(k.y >> 16);
        const float r2 = rsqrtf(wave_sum(g0 * g0 + g1 * g1 + g2 * g2 + g3 * g3) * (1.0f / 256.0f) + EPS);
        u32x2 o2; o2.x = pk2(g0 * r2 * kn[0], g1 * r2 * kn[1]); o2.y = pk2(g2 * r2 * kn[2], g3 * r2 * kn[3]);
        *(u32x2*)(KVN + (size_t)row * 256 + 4 * lane) = o2;
    }
}
DI void task_transpose(const bf16_t* src, int sp, bf16_t* dst, int dp, int nrt, int nct, unsigned char* lds, int vb = -1, int vg = 0) {
    const int lane = mk_otid() & 63, wave = mk_otid() >> 6, gw = (vb >= 0 ? vb : (int)blockIdx.x) * 8 + wave, NGW = (vb >= 0 ? vg : (int)gridDim.x) * 8;
    bf16_t* tile = (bf16_t*)(lds + wave * 9216);
    for (int tl = gw; tl < nrt * nct; tl += 2 * NGW) {
        const int tl2 = tl + NGW; const bool two = tl2 < nrt * nct;
        const int ct = tl % nct, rt = tl / nct, ct2 = two ? tl2 % nct : ct, rt2 = two ? tl2 / nct : rt;
        u32x4 va[8], vb[8];
#pragma unroll
        for (int it = 0; it < 8; ++it) { const int rr = 8 * it + (lane >> 3), ch = lane & 7;
            va[it] = *(const u32x4*)(src + (size_t)(64 * rt + rr) * sp + 64 * ct + 8 * ch); vb[it] = *(const u32x4*)(src + (size_t)(64 * rt2 + rr) * sp + 64 * ct2 + 8 * ch); }
#pragma unroll
        for (int pass = 0; pass < 2; ++pass) {
            if (pass == 1 && !two) break;
            const int cct = pass ? ct2 : ct, rrt = pass ? rt2 : rt;
#pragma unroll
            for (int it = 0; it < 8; ++it) { const int rr = 8 * it + (lane >> 3), ch = lane & 7; *(u32x4*)(tile + rr * 72 + 8 * (ch ^ it)) = pass ? vb[it] : va[it]; }
            __builtin_amdgcn_s_waitcnt(0xc07f); __builtin_amdgcn_wave_barrier();
#pragma unroll
            for (int it = 0; it < 8; ++it) { const int j = 8 * it + (lane >> 3), tc = lane & 7; const bf16_t* s = tile + (8 * tc) * 72 + 8 * (it ^ tc) + (lane >> 3);
                u32x4 o; o.x = (unsigned)s[0] | ((unsigned)s[72] << 16); o.y = (unsigned)s[144] | ((unsigned)s[216] << 16); o.z = (unsigned)s[288] | ((unsigned)s[360] << 16); o.w = (unsigned)s[432] | ((unsigned)s[504] << 16);
                *(u32x4*)(dst + (size_t)(64 * cct + j) * dp + 64 * rrt + 8 * tc) = o; }
            __builtin_amdgcn_s_waitcnt(0xc07f); __builtin_amdgcn_wave_barrier();
        }
    }
}
DI float wscan_add(float v, int lane) {
#pragma unroll
    for (int o = 1; o < 64; o <<= 1) { const float t = __shfl_up(v, o); if (lane >= o) v += t; }
    return v; }
DI float wscan_max_up(float v, int lane) {
#pragma unroll
    for (int o = 1; o < 64; o <<= 1) { const float t = __shfl_up(v, o); if (lane >= o) v = fmaxf(v, t); }
    return v; }
DI float wscan_max_down(float v, int lane) {
#pragma unroll
    for (int o = 1; o < 64; o <<= 1) { const float t = __shfl_down(v, o); if (lane + o < 64) v = fmaxf(v, t); }
    return v; }
DI float wave_max(float v) {
#pragma unroll
    for (int o = 1; o < 64; o <<= 1) v = fmaxf(v, mk_shx(v, o));
    return v; }
DI float fexp(float x) { return __builtin_amdgcn_exp2f(x * 1.4426950408889634f); }
DI float frcp(float x) { return __builtin_amdgcn_rcpf(x); }
DI void mlstm_step1_unit(const Args& a, int layer, int u, unsigned char* lds) {
    const int tid = mk_otid(), lane = tid & 63, wave = __builtin_amdgcn_readfirstlane(tid >> 6), r = lane & 31, h = lane >> 5;
    const int b = u / (4 * NCHK), head = (u / NCHK) & 3, sc = u % NCHK; const bool isctx = sc < 2; const int ci = isctx ? sc : sc - 2;
    const int row0 = isctx ? NLAT + 256 * b + 128 * ci : 4096 * b + 128 * ci;
    float* li = (float*)lds; float* lf = li + 256; float* wv = li + 512;
    bf16_t* KT = (bf16_t*)(lds + 4096); bf16_t* VT0 = (bf16_t*)(lds + 4096 + 34816); bf16_t* VT1 = (bf16_t*)(lds + 4096 + 2 * 34816);
    const bf16_t* P = (const bf16_t*)(a.ws + WS_P); const float* gb = a.in[21] + layer * 16;
    const int ck0 = ((b * 8 + head * 2) * NCHK) + sc, ck1 = ((b * 8 + head * 2 + 1) * NCHK) + (isctx ? 1 - ci : 35 - sc);
    u32x4 kr4[4], vr4[4];
#pragma unroll
    for (int it = 0; it < 4; ++it) { const int idx = tid + 512 * it, s = idx & 127, f0 = (idx >> 7) * 8;
        kr4[it] = *(const u32x4*)(P + (size_t)(row0 + s) * INP + OFF_MK + head * 128 + f0); vr4[it] = *(const u32x4*)(P + (size_t)(row0 + s) * INP + OFF_MV + head * 128 + f0); }
    if (tid < 256) { const int dir = tid >> 7, s = tid & 127; const bf16_t* g = P + (size_t)(row0 + s) * INP + OFF_MG;
        li[dir * 128 + s] = bf2f(g[(2 * dir) * 4 + head]) + gb[(2 * dir) * 4 + head]; lf[dir * 128 + s] = logsigmoid(bf2f(g[(2 * dir + 1) * 4 + head]) + gb[(2 * dir + 1) * 4 + head]); }
    __syncthreads();
    if (tid < 128) {
        const int dir = wave; const float* lfd = lf + dir * 128; const float* lid = li + dir * 128;
        const float f0 = lfd[2 * lane], f1 = lfd[2 * lane + 1];
        const float inc = wscan_add(f0 + f1, lane), total = __shfl(inc, 63);
        const float p0 = inc - f1, p1 = inc;
        const float lw0 = (dir == 0 ? total - p0 : p0 - f0) + lid[2 * lane], lw1 = (dir == 0 ? total - p1 : p1 - f1) + lid[2 * lane + 1];
        const float mx = wave_max(fmaxf(lw0, lw1));
        wv[dir * 128 + 2 * lane] = fexp(lw0 - mx); wv[dir * 128 + 2 * lane + 1] = fexp(lw1 - mx);
        if (lane == 0) { float* ML = (float*)(a.ws + WS_ML) + (size_t)(dir ? ck1 : ck0) * 2; ML[0] = total; ML[1] = mx; }
    }
    __syncthreads();
#pragma unroll
    for (int it = 0; it < 4; ++it) { const int idx = tid + 512 * it, s = idx & 127, f0 = (idx >> 7) * 8;
        const u32x4 kr = kr4[it], vr = vr4[it];
        const float w0 = wv[s], w1 = wv[128 + s];
#pragma unroll
        for (int e = 0; e < 4; ++e) { const float k0 = bf2f(kr[e] & 0xffffu) * 0.08838834764831845f, k1 = bf2f(kr[e] >> 16) * 0.08838834764831845f, v0 = bf2f(vr[e] & 0xffffu), v1 = bf2f(vr[e] >> 16);
            KT[(f0 + 2 * e) * 136 + s] = f2bf(k0); KT[(f0 + 2 * e + 1) * 136 + s] = f2bf(k1);
            VT0[(f0 + 2 * e) * 136 + s] = f2bf(v0 * w0); VT0[(f0 + 2 * e + 1) * 136 + s] = f2bf(v1 * w0);
            VT1[(f0 + 2 * e) * 136 + s] = f2bf(v0 * w1); VT1[(f0 + 2 * e + 1) * 136 + s] = f2bf(v1 * w1); } }
    __syncthreads();
#pragma unroll
    for (int q = 0; q < 4; ++q) { const int id = 4 * wave + q, dir = id >> 4, vt = (id >> 2) & 3, dt = id & 3; const bf16_t* VTd = dir ? VT1 : VT0;
        bf16_t* DC = (bf16_t*)(a.ws + WS_DC) + (size_t)(dir ? ck1 : ck0) * CSTATE;
        f32x16 acc = zero16();
#pragma unroll
        for (int st = 0; st < 8; ++st) { const bf16x8 A = *(const bf16x8*)(VTd + (32 * vt + r) * 136 + 16 * st + 8 * h), B = *(const bf16x8*)(KT + (32 * dt + r) * 136 + 16 * st + 8 * h); acc = MFMA32(A, B, acc); }
#pragma unroll
        for (int reg = 0; reg < 16; ++reg) DC[(32 * vt + crow(reg, h)) * 128 + 32 * dt + r] = f2bf(acc[reg]); }
    {
        const int dir = tid >> 8, d = (tid >> 1) & 127, hf = tid & 1; float s0 = 0.f, s1 = 0.f;
        const unsigned* kt2 = (const unsigned*)(KT + d * 136 + 64 * hf); const float* wp = wv + dir * 128 + 64 * hf;
#pragma unroll 8
        for (int t = 0; t < 32; ++t) { const unsigned kk = kt2[t]; s0 += wp[2 * t] * bf2f(kk & 0xffffu); s1 += wp[2 * t + 1] * bf2f(kk >> 16); }
        float s = s0 + s1; s += mk_shx(s, 1);
        if (hf == 0) ((bf16_t*)(a.ws + WS_DC))[(size_t)(dir ? ck1 : ck0) * CSTATE + 16384 + d] = f2bf(s); }
    __syncthreads();
}
DI void task_mlstm_scan(const Args& a) {
    const int gt = blockIdx.x * 512 + mk_otid(), NGT = gridDim.x * 512;
    const bf16_t* DC = (const bf16_t*)(a.ws + WS_DC); const float* ML = (const float*)(a.ws + WS_ML);
    bf16_t* CIN = (bf16_t*)(a.ws + WS_CIN); float* NIN = (float*)(a.ws + WS_NIN); float* MIN_ = (float*)(a.ws + WS_MIN);
    for (int e = gt; e < NCHAIN * CSTATE; e += NGT) {
        const int chain = e / CSTATE, el = e % CSTATE; float m = 0.f, cv = 0.f;
        const bf16_t* dcp = DC + (size_t)chain * NCHK * CSTATE + el; const float* mlp = ML + chain * NCHK * 2;
        float dq[34], tq[34], mq[34];
#pragma unroll 1
        for (int kb = 0; kb < NCHK; kb += 34) {
#pragma unroll
            for (int j = 0; j < 34; ++j) { dq[j] = bf2f(dcp[(size_t)(kb + j) * CSTATE]); const f32x2 tm = *(const f32x2*)(mlp + (kb + j) * 2); tq[j] = tm.x; mq[j] = tm.y; }
#pragma unroll
            for (int j = 0; j < 34; ++j) { const int ck = chain * NCHK + kb + j;
                if (el < 16384) CIN[(size_t)ck * 16384 + el] = f2bf(cv); else NIN[ck * 128 + el - 16384] = cv;
                if (el == 0) MIN_[ck] = m;
                const float mn = fmaxf(tq[j] + m, mq[j]);
                cv = fexp(tq[j] + m - mn) * cv + fexp(mq[j] - mn) * dq[j]; m = mn; }
        }
    }
}
DI void mlstm_step3_unit(const Args& a, int layer, int u, unsigned char* lds) {
    const int tid = mk_otid(), lane = tid & 63, wave = __builtin_amdgcn_readfirstlane(tid >> 6), r = lane & 31, h = lane >> 5;
    const int b = u / (4 * NCHK), head = (u / NCHK) & 3, sc = u % NCHK; const bool isctx = sc < 2; const int ci = isctx ? sc : sc - 2;
    const int row0 = isctx ? NLAT + 256 * b + 128 * ci : 4096 * b + 128 * ci;
    bf16_t* Qs = (bf16_t*)lds; bf16_t* Ks = (bf16_t*)(lds + 34816); bf16_t* VT = (bf16_t*)(lds + 69632);
    float* li = (float*)(lds + 104448); float* lf = li + 256; float* aarr = li + 512; float* Mt = li + 768; float* cumM = li + 1024; float* nvec = li + 1280; float* red = li + 1536;
    const bf16_t* P = (const bf16_t*)(a.ws + WS_P); const float* gb = a.in[21] + layer * 16;
    const int ck0 = ((b * 8 + head * 2) * NCHK) + sc, ck1 = ((b * 8 + head * 2 + 1) * NCHK) + (isctx ? 1 - ci : 35 - sc);
    const int tt = wave & 3, vh = wave >> 2, t = 32 * tt + r;
    const float m_in0 = ((const float*)(a.ws + WS_MIN))[ck0], m_in1 = ((const float*)(a.ws + WS_MIN))[ck1];
    if (tid < 256) { const int dir = tid >> 7, s = tid & 127; const bf16_t* g = P + (size_t)(row0 + s) * INP + OFF_MG;
        nvec[dir * 128 + s] = ((const float*)(a.ws + WS_NIN))[(dir ? ck1 : ck0) * 128 + s];
        li[dir * 128 + s] = bf2f(g[(2 * dir) * 4 + head]) + gb[(2 * dir) * 4 + head]; lf[dir * 128 + s] = logsigmoid(bf2f(g[(2 * dir + 1) * 4 + head]) + gb[(2 * dir + 1) * 4 + head]); }
    {
        u32x4 qr[4], kr[4], vr[4];
#pragma unroll
        for (int it = 0; it < 4; ++it) { const int idx = tid + 512 * it, s = idx & 127, f0 = (idx >> 7) * 8; const bf16_t* pr = P + (size_t)(row0 + s) * INP + head * 128 + f0;
            qr[it] = *(const u32x4*)(pr + OFF_MQ); kr[it] = *(const u32x4*)(pr + OFF_MK); vr[it] = *(const u32x4*)(pr + OFF_MV); }
#pragma unroll
        for (int it = 0; it < 4; ++it) { const int idx = tid + 512 * it, s = idx & 127, f0 = (idx >> 7) * 8; u32x4 ks;
#pragma unroll
            for (int e = 0; e < 4; ++e) { ks[e] = pk2(bf2f(kr[it][e] & 0xffffu) * 0.08838834764831845f, bf2f(kr[it][e] >> 16) * 0.08838834764831845f);
                VT[(f0 + 2 * e) * 136 + s] = (bf16_t)(vr[it][e] & 0xffffu); VT[(f0 + 2 * e + 1) * 136 + s] = (bf16_t)(vr[it][e] >> 16); }
            *(u32x4*)(Qs + s * 136 + f0) = qr[it]; *(u32x4*)(Ks + s * 136 + f0) = ks; } }
    bf16x8 cf[16];
    { const bf16_t* C0 = (const bf16_t*)(a.ws + WS_CIN) + (size_t)ck0 * 16384 + (size_t)(64 * vh + r) * 128 + 8 * h;
#pragma unroll
      for (int j = 0; j < 2; ++j)
#pragma unroll
          for (int st = 0; st < 8; ++st) cf[j * 8 + st] = *(const bf16x8*)(C0 + j * 32 * 128 + 16 * st); }
    __syncthreads();
    if (tid < 128) {
        const int dir = wave; const float m_in = dir ? m_in1 : m_in0; const float* lfd = lf + dir * 128; const float* lid = li + dir * 128;
        const float f0 = lfd[2 * lane], f1 = lfd[2 * lane + 1];
        const float inc = wscan_add(f0 + f1, lane), total = __shfl(inc, 63);
        const float p0 = inc - f1, p1 = inc;
        const float c0 = dir == 0 ? p0 : total - p0 + f0, c1 = dir == 0 ? p1 : total - p1 + f1;
        const float a0 = lid[2 * lane] - c0, a1 = lid[2 * lane + 1] - c1;
        float A0, A1;
        if (dir == 0) { const float scn = wscan_max_up(fmaxf(a0, a1), lane); const float prev = __shfl_up(scn, 1); A0 = lane > 0 ? fmaxf(prev, a0) : a0; A1 = scn; }
        else { const float scn = wscan_max_down(fmaxf(a0, a1), lane); const float nxt = __shfl_down(scn, 1); A1 = lane < 63 ? fmaxf(nxt, a1) : a1; A0 = scn; }
        const float M0 = fmaxf(m_in, A0), M1 = fmaxf(m_in, A1);
        aarr[dir * 128 + 2 * lane] = a0; aarr[dir * 128 + 2 * lane + 1] = a1; Mt[dir * 128 + 2 * lane] = M0; Mt[dir * 128 + 2 * lane + 1] = M1; cumM[dir * 128 + 2 * lane] = c0 + M0; cumM[dir * 128 + 2 * lane + 1] = c1 + M1;
    }
    __syncthreads();
    bf16x8 qf[8];
#pragma unroll
    for (int st = 0; st < 8; ++st) qf[st] = *(const bf16x8*)(Qs + t * 136 + 16 * st + 8 * h);
    f32x16 hs0 = zero16(), hs1 = zero16();
#pragma unroll 1
    for (int dir = 0; dir < 2; ++dir) {
        const float m_in = dir ? m_in1 : m_in0; const float* aar = aarr + dir * 128; const float* nv = nvec + dir * 128;
        const float Mq = Mt[dir * 128 + t], winter = fexp(m_in - Mq);
        f32x16 n0 = zero16(), n1 = zero16();
#pragma unroll
        for (int st = 0; st < 8; ++st) { n0 = MFMA32(cf[st], qf[st], n0); n1 = MFMA32(cf[8 + st], qf[st], n1); }
        if (dir == 0) {
            const bf16_t* C1 = (const bf16_t*)(a.ws + WS_CIN) + (size_t)ck1 * 16384 + (size_t)(64 * vh + r) * 128 + 8 * h;
#pragma unroll
            for (int j = 0; j < 2; ++j)
#pragma unroll
                for (int st = 0; st < 8; ++st) cf[j * 8 + st] = *(const bf16x8*)(C1 + j * 32 * 128 + 16 * st); }
        float nq = 0.f;
#pragma unroll
        for (int st = 0; st < 8; ++st)
#pragma unroll
            for (int j = 0; j < 8; ++j) nq += nv[16 * st + 8 * h + j] * bf2f((unsigned)(unsigned short)qf[st][j]);
        nq += mk_shx(nq, 32);
#pragma unroll
        for (int reg = 0; reg < 16; ++reg) { n0[reg] *= winter; n1[reg] *= winter; }
        float dsum = 0.f;
        const int si_lo = dir ? tt : 0, si_hi = dir ? 3 : tt;
#pragma unroll 1
        for (int si = si_lo; si <= si_hi; ++si) {
            f32x16 S = zero16();
#pragma unroll
            for (int st = 0; st < 8; ++st) { const bf16x8 A = *(const bf16x8*)(Ks + (32 * si + r) * 136 + 16 * st + 8 * h); S = MFMA32(A, qf[st], S); }
#pragma unroll
            for (int reg = 0; reg < 16; ++reg) { const int s = 32 * si + crow(reg, h); const bool ok = dir ? (s >= t) : (s <= t);
                const float ex = (si != tt || ok) ? (aar[s] - Mq) * 1.4426950408889634f : -1.0e30f; const float dv = __builtin_amdgcn_exp2f(ex); S[reg] *= dv; dsum += S[reg]; }
            const bf16x8 pb0 = pack8(S, 0), pb1 = pack8(S, 1);
            const bf16_t* v0 = VT + (64 * vh + r) * 136 + 32 * si + 4 * h; const bf16_t* v1 = v0 + 32 * 136;
            n0 = MFMA32(ld2x8(v0, v0 + 8), pb0, n0); n0 = MFMA32(ld2x8(v0 + 16, v0 + 24), pb1, n0);
            n1 = MFMA32(ld2x8(v1, v1 + 8), pb0, n1); n1 = MFMA32(ld2x8(v1 + 16, v1 + 24), pb1, n1);
        }
        dsum += mk_shx(dsum, 32);
        const float den = winter * nq + dsum, dn = fmaxf(fabsf(den), fexp(-cumM[dir * 128 + t])), inv = frcp(dn);
#pragma unroll
        for (int reg = 0; reg < 16; ++reg) { hs0[reg] += n0[reg] * inv; hs1[reg] += n1[reg] * inv; }
    }
    u32x2 ovp[8];
    { const bf16_t* og = P + (size_t)(row0 + t) * INP + OFF_MO + head * 128;
#pragma unroll
      for (int vt2 = 0; vt2 < 2; ++vt2)
#pragma unroll
          for (int g4 = 0; g4 < 4; ++g4) ovp[vt2 * 4 + g4] = *(const u32x2*)(og + 64 * vh + 32 * vt2 + 8 * g4 + 4 * h); }
    float ss = 0.f;
#pragma unroll
    for (int reg = 0; reg < 16; ++reg) ss += hs0[reg] * hs0[reg] + hs1[reg] * hs1[reg];
    ss += mk_shx(ss, 32);
    if (h == 0) red[vh * 128 + t] = ss;
    __syncthreads();
    const float rstd = rsqrtf((red[t] + red[128 + t]) * (1.0f / 128.0f) + EPS);
    const float* gn = a.in[22] + layer * 512 + head * 128; bf16_t* MIX = (bf16_t*)(a.ws + WS_MIX) + (size_t)(row0 + t) * DM + 1024 + head * 128;
#pragma unroll
    for (int vt2 = 0; vt2 < 2; ++vt2)
#pragma unroll
        for (int g4 = 0; g4 < 4; ++g4) { const int v0 = 64 * vh + 32 * vt2 + 8 * g4 + 4 * h; const u32x2 ov = ovp[vt2 * 4 + g4];
            float o[4] = {bf2f(ov.x & 0xffffu), bf2f(ov.x >> 16), bf2f(ov.y & 0xffffu), bf2f(ov.y >> 16)}; float y[4];
#pragma unroll
            for (int e = 0; e < 4; ++e) { const float hv = (vt2 ? hs1[4 * g4 + e] : hs0[4 * g4 + e]) * rstd * gn[v0 + e]; y[e] = hv * frcp(1.0f + fexp(-o[e])); }
            u32x2 w; w.x = pk2(y[0], y[1]); w.y = pk2(y[2], y[3]); *(u32x2*)(MIX + v0) = w; }
    __syncthreads();
}

DI float max3f(float a, float b, float c) { return fmaxf(a, fmaxf(b, c)); }
DI float xhalf_max(float v) { const auto rr = __builtin_amdgcn_permlane32_swap(__float_as_uint(v), __float_as_uint(v), false, false); return fmaxf(__uint_as_float(rr[0]), __uint_as_float(rr[1])); }
DI void attn_tile(f32x16& o0, f32x16& o1, float& m, float& l, f32x16 x, float sl2, bool mask, int qpos, int kpos0, int h, const bf16_t* vp, size_t dts) {
    float tmax = -3.0e38f;
#pragma unroll
    for (int reg = 0; reg < 16; ++reg) { if (mask) { const int dd = qpos - (kpos0 + crow(reg, h)); if (dd > 128 || dd < -128) x[reg] = -1.0e30f; } }
#pragma unroll
    for (int reg = 0; reg < 16; reg += 2) tmax = max3f(tmax, x[reg], x[reg + 1]);
    tmax = xhalf_max(tmax);
    if (__any(tmax > m)) {
        const float mn = fmaxf(m, tmax), alpha = __builtin_amdgcn_exp2f(m - mn); m = mn; l *= alpha;
#pragma unroll
        for (int reg = 0; reg < 16; ++reg) { o0[reg] *= alpha; o1[reg] *= alpha; }
    }
    float ps = 0.f;
#pragma unroll
    for (int reg = 0; reg < 16; ++reg) { const float p = __builtin_amdgcn_exp2f(x[reg] - m); x[reg] = p; ps += p; }
    l += ps;
    const bf16x8 pb0 = pack8(x, 0), pb1 = pack8(x, 1);
    o0 = MFMA32(ld2x8(vp, vp + 8), pb0, o0); o0 = MFMA32(ld2x8(vp + 16, vp + 24), pb1, o0);
    o1 = MFMA32(ld2x8(vp + dts, vp + dts + 8), pb0, o1); o1 = MFMA32(ld2x8(vp + dts + 16, vp + dts + 24), pb1, o1);
}
DI void attn_tile2(f32x16& o0, f32x16& o1, float& m, float& l, f32x16 x0, f32x16 x1, float sl2, int h, const bf16_t* vp  , int dts  ) {
    float tmax = -3.0e38f;
#pragma unroll
    for (int reg = 0; reg < 16; ++reg) tmax = max3f(tmax, x0[reg], x1[reg]);
    tmax = xhalf_max(tmax);
    if (__any(tmax > m)) {
        const float mn = fmaxf(m, tmax), alpha = __builtin_amdgcn_exp2f(m - mn); m = mn; l *= alpha;
#pragma unroll
        for (int reg = 0; reg < 16; ++reg) { o0[reg] *= alpha; o1[reg] *= alpha; }
    }
    float ps = 0.f;
#pragma unroll
    for (int reg = 0; reg < 16; ++reg) { const float p0 = __builtin_amdgcn_exp2f(x0[reg] - m), p1 = __builtin_amdgcn_exp2f(x1[reg] - m); x0[reg] = p0; x1[reg] = p1; ps += p0 + p1; }
    l += ps;
    const bf16x8 pa0 = pack8(x0, 0), pa1 = pack8(x0, 1), pb0 = pack8(x1, 0), pb1 = pack8(x1, 1);
    o0 = MFMA32(*(const bf16x8*)(vp), pa0, o0);            o1 = MFMA32(*(const bf16x8*)(vp + dts), pa0, o1);
    o0 = MFMA32(*(const bf16x8*)(vp + 16), pa1, o0);       o1 = MFMA32(*(const bf16x8*)(vp + dts + 16), pa1, o1);
    o0 = MFMA32(*(const bf16x8*)(vp + 32), pb0, o0);       o1 = MFMA32(*(const bf16x8*)(vp + dts + 32), pb0, o1);
    o0 = MFMA32(*(const bf16x8*)(vp + 48), pb1, o0);       o1 = MFMA32(*(const bf16x8*)(vp + dts + 48), pb1, o1);
}
DI int imax3(int a, int b, int c) { const int t = a > b ? a : b; return t > c ? t : c; }
DI float bf16_round(float x) { return bf2f(pk2(x, 0.f) & 0xffffu); }
DI void attn_tile4(f32x16& o0, f32x16& o1, f32x16& lacc, float& m, bf16x8& q6, f32x16 x0, f32x16 x1, int h, const bf16_t* vp  , int dts  , unsigned ones2  ) {
    int ti = (int)0x80000000;
#pragma unroll
    for (int reg = 0; reg < 16; ++reg) ti = imax3(ti, __float_as_int(x0[reg]), __float_as_int(x1[reg]));
    { const auto rr = __builtin_amdgcn_permlane32_swap((unsigned)ti, (unsigned)ti, false, false); const int a = (int)rr[0], b = (int)rr[1]; ti = a > b ? a : b; }
    const float tmax = __int_as_float(ti);
    if (__any(tmax > 8.0f)) {
        const float mn = tmax > 8.0f ? bf16_round(m + tmax) : m, d = mn - m, alpha = __builtin_amdgcn_exp2f(-d); m = mn;
#pragma unroll
        for (int reg = 0; reg < 16; ++reg) { o0[reg] *= alpha; o1[reg] *= alpha; lacc[reg] *= alpha; x0[reg] -= d; x1[reg] -= d; }
        u32x4 qq = {h ? 0u : (pk2(-m, 0.f) & 0xffffu), 0u, 0u, 0u}; q6 = __builtin_bit_cast(bf16x8, qq);
    }
#pragma unroll
    for (int reg = 0; reg < 16; ++reg) { x0[reg] = __builtin_amdgcn_exp2f(x0[reg]); x1[reg] = __builtin_amdgcn_exp2f(x1[reg]); }
    const bf16x8 pa0 = pack8(x0, 0), pa1 = pack8(x0, 1), pb0 = pack8(x1, 0), pb1 = pack8(x1, 1);
    const u32x4 ones_w = {ones2, ones2, ones2, ones2}; const bf16x8 ones = __builtin_bit_cast(bf16x8, ones_w);
    o0 = MFMA32(*(const bf16x8*)(vp), pa0, o0);            o1 = MFMA32(*(const bf16x8*)(vp + dts), pa0, o1);            lacc = MFMA32(ones, pa0, lacc);
    o0 = MFMA32(*(const bf16x8*)(vp + 16), pa1, o0);       o1 = MFMA32(*(const bf16x8*)(vp + dts + 16), pa1, o1);       lacc = MFMA32(ones, pa1, lacc);
    o0 = MFMA32(*(const bf16x8*)(vp + 32), pb0, o0);       o1 = MFMA32(*(const bf16x8*)(vp + dts + 32), pb0, o1);       lacc = MFMA32(ones, pb0, lacc);
    o0 = MFMA32(*(const bf16x8*)(vp + 48), pb1, o0);       o1 = MFMA32(*(const bf16x8*)(vp + dts + 48), pb1, o1);       lacc = MFMA32(ones, pb1, lacc);
}
DI void attn_store_l(const f32x16& o0, const f32x16& o1, float lt, int h, bf16_t* dst) {
    const float inv = 1.0f / lt;
#pragma unroll
    for (int g4 = 0; g4 < 4; ++g4) { u32x2 w0, w1;
        w0.x = pk2(o0[4 * g4] * inv, o0[4 * g4 + 1] * inv); w0.y = pk2(o0[4 * g4 + 2] * inv, o0[4 * g4 + 3] * inv);
        w1.x = pk2(o1[4 * g4] * inv, o1[4 * g4 + 1] * inv); w1.y = pk2(o1[4 * g4 + 2] * inv, o1[4 * g4 + 3] * inv);
        *(u32x2*)(dst + 8 * g4 + 4 * h) = w0; *(u32x2*)(dst + 32 + 8 * g4 + 4 * h) = w1; }
}
DI void attn_store(const f32x16& o0, const f32x16& o1, float l, int h, bf16_t* dst  ) {
    const float lt = l + mk_shx(l, 32), inv = 1.0f / lt;
#pragma unroll
    for (int g4 = 0; g4 < 4; ++g4) { u32x2 w0, w1;
        w0.x = pk2(o0[4 * g4] * inv, o0[4 * g4 + 1] * inv); w0.y = pk2(o0[4 * g4 + 2] * inv, o0[4 * g4 + 3] * inv);
        w1.x = pk2(o1[4 * g4] * inv, o1[4 * g4 + 1] * inv); w1.y = pk2(o1[4 * g4 + 2] * inv, o1[4 * g4 + 3] * inv);
        *(u32x2*)(dst + 8 * g4 + 4 * h) = w0; *(u32x2*)(dst + 32 + 8 * g4 + 4 * h) = w1; }
}
constexpr int GQ_P = 72, GQ_BUF = 2 * 64 * GQ_P * 2;
DI void gqa_tile(f32x16& o0, f32x16& o1, f32x2& l2, float& m, bf16x8& q4, const bf16x8 (&qf)[4], const bf16_t* Kt, bool edge, int qpos, int kpos0, int r, int h) {
    const bf16_t* Vt = Kt + 64 * GQ_P;
    const bf16_t* kp0 = Kt + r * GQ_P + 8 * h; const bf16_t* kp1 = kp0 + 32 * GQ_P;
    f32x16 S0 = zero16(), S1 = zero16();
#pragma unroll
    for (int s = 0; s < 4; ++s) { S0 = MFMA32(*(const bf16x8*)(kp0 + 16 * s), qf[s], S0); S1 = MFMA32(*(const bf16x8*)(kp1 + 16 * s), qf[s], S1); }
    S0 = MFMA32(*(const bf16x8*)(kp0 + 64), q4, S0); S1 = MFMA32(*(const bf16x8*)(kp1 + 64), q4, S1);
    if (edge) {
#pragma unroll
        for (int reg = 0; reg < 16; ++reg) { const int dd = qpos - (kpos0 + crow(reg, h)); if (dd > 128 || dd < -128) S0[reg] = -1.0e30f; if (dd > 160 || dd < -96) S1[reg] = -1.0e30f; } }
    int ti = (int)0x80000000;
#pragma unroll
    for (int reg = 0; reg < 16; ++reg) ti = imax3(ti, __float_as_int(S0[reg]), __float_as_int(S1[reg]));
    { const auto rr = __builtin_amdgcn_permlane32_swap((unsigned)ti, (unsigned)ti, false, false); const int a_ = (int)rr[0], b_ = (int)rr[1]; ti = a_ > b_ ? a_ : b_; }
    const float tmax = __int_as_float(ti);
    if (__any(tmax > 8.0f)) {
        const float mn = tmax > 8.0f ? bf16_round(m + tmax) : m, d = mn - m, alpha = __builtin_amdgcn_exp2f(-d); m = mn;
#pragma unroll
        for (int reg = 0; reg < 16; ++reg) { o0[reg] *= alpha; o1[reg] *= alpha; S0[reg] -= d; S1[reg] -= d; }
        l2 *= alpha;
        u32x4 qq = {h ? 0u : (pk2(-m, 0.f) & 0xffffu), 0u, 0u, 0u}; q4 = __builtin_bit_cast(bf16x8, qq);
    }
#pragma unroll
    for (int reg = 0; reg < 16; ++reg) { S0[reg] = __builtin_amdgcn_exp2f(S0[reg]); S1[reg] = __builtin_amdgcn_exp2f(S1[reg]); }
#pragma unroll
    for (int reg = 0; reg < 16; reg += 2) { l2 += (f32x2){S0[reg], S0[reg + 1]}; l2 += (f32x2){S1[reg], S1[reg + 1]}; }
    const bf16x8 pa0 = pack8(S0, 0), pa1 = pack8(S0, 1), pb0 = pack8(S1, 0), pb1 = pack8(S1, 1);
    const bf16_t* vp = Vt + r * GQ_P + 8 * h;
    o0 = MFMA32(*(const bf16x8*)(vp), pa0, o0);      o1 = MFMA32(*(const bf16x8*)(vp + 32 * GQ_P), pa0, o1);
    o0 = MFMA32(*(const bf16x8*)(vp + 16), pa1, o0); o1 = MFMA32(*(const bf16x8*)(vp + 32 * GQ_P + 16), pa1, o1);
    o0 = MFMA32(*(const bf16x8*)(vp + 32), pb0, o0); o1 = MFMA32(*(const bf16x8*)(vp + 32 * GQ_P + 32), pb0, o1);
    o0 = MFMA32(*(const bf16x8*)(vp + 48), pb1, o0); o1 = MFMA32(*(const bf16x8*)(vp + 32 * GQ_P + 48), pb1, o1);
}
DI void gqa_unit(const Args& a, int layer, int u, unsigned char* lds) {
    const int tid = mk_otid(), lane = tid & 63, wave = __builtin_amdgcn_readfirstlane(tid >> 6), r = lane & 31, h = lane >> 5;
    const bf16_t* P = (const bf16_t*)(a.ws + WS_P); const bf16_t* PT2 = (const bf16_t*)(a.ws + WS_PT2); bf16_t* MIX = (bf16_t*)(a.ws + WS_MIX);
    const bool lat = u < 256; const int uu = lat ? u : u - 256;
    const int b = lat ? (uu >> 7) : (uu >> 3), kvh = lat ? ((uu >> 6) & 1) : ((uu >> 2) & 1), qblk = lat ? (uu & 63) : (uu & 3);
    const int head = 4 * kvh + (wave >> 1), qt = wave & 1, t0 = 64 * qblk, qlo = t0 + 32 * qt, qrow = (lat ? 4096 * b : NLAT + 256 * b) + qlo + r;
    bf16x8 qf[4];
#pragma unroll
    for (int s = 0; s < 4; ++s) qf[s] = *(const bf16x8*)(P + (size_t)qrow * INP + 64 * head + 16 * s + 8 * h);
    const float sink = a.in[12][layer * 8 + head] * LOG2E;
    f32x16 o0 = zero16(), o1 = zero16(); float m = bf16_round(sink); f32x2 l2 = {h ? 0.f : __builtin_amdgcn_exp2f(sink - m), 0.f};
    unsigned c_one = 0x3f80u, c_zero = 0u; asm volatile("" : "+v"(c_one), "+v"(c_zero));
    bf16x8 q4; { u32x4 qq = {h ? c_zero : (pk2(-m, 0.f) & 0xffffu), c_zero, c_zero, c_zero}; q4 = __builtin_bit_cast(bf16x8, qq); }
    *(u32x4*)((bf16_t*)(lds + (tid >> 6) * GQ_BUF) + (tid & 63) * GQ_P + 64) = (u32x4){c_one, c_zero, c_zero, c_zero};
    const int bs = t0 - 128 < 0 ? 0 : t0 - 128, be = t0 + 192 > SEQ ? SEQ : t0 + 192, nt = lat ? 4 + ((be - bs) >> 6) : 4;
    const int lkey = tid >> 3, lch = tid & 7;
#define GQ_GLOAD(tn_, gk_, gv_) do { const int tc_ = (tn_) < nt ? (tn_) : nt - 1; const int krow0_ = tc_ < 4 ? NLAT + 256 * b + 64 * tc_ : 4096 * b + bs + 64 * (tc_ - 4); \
        gk_ = *(const u32x4*)(P + (size_t)(krow0_ + lkey) * INP + OFF_AK + 64 * kvh + 8 * lch); \
        gv_ = *(const u32x4*)(PT2 + (size_t)(64 * kvh + lkey) * MROWS + krow0_ + 8 * lch); } while (0)
#define GQ_LWRITE(slot_, gk_, gv_) do { bf16_t* Kn_ = (bf16_t*)(lds + (slot_) * GQ_BUF); bf16_t* Vn_ = Kn_ + 64 * GQ_P; \
        *(u32x4*)(Kn_ + lkey * GQ_P + 8 * lch) = gk_; \
        { bf16_t* vd_ = Vn_ + lkey * GQ_P + 16 * (lch >> 1) + 4 * (lch & 1); *(u32x2*)vd_ = (u32x2){gv_.x, gv_.y}; *(u32x2*)(vd_ + 8) = (u32x2){gv_.z, gv_.w}; } } while (0)
#define GQ_TILES(lo_, hi_) do { _Pragma("unroll 1") for (int t = (lo_); t < (hi_); ++t) { const int kpos0 = bs + 64 * (t - 4); \
        const bool band = t >= 4, skip = band && (kpos0 + 63 < qlo - 128 || kpos0 > qlo + 31 + 128), edge = band && (kpos0 < qlo + 31 - 128 || kpos0 + 63 > qlo + 128); \
        if (!skip) gqa_tile(o0, o1, l2, m, q4, qf, (const bf16_t*)(lds + (t & 7) * GQ_BUF), edge, qlo + r, kpos0, r, h); } } while (0)
    u32x4 k0, v0, k1, v1, k2, v2, k3, v3;
    GQ_GLOAD(0, k0, v0); GQ_GLOAD(1, k1, v1); GQ_GLOAD(2, k2, v2); GQ_GLOAD(3, k3, v3);
    GQ_LWRITE(0, k0, v0); GQ_LWRITE(1, k1, v1); GQ_LWRITE(2, k2, v2); GQ_LWRITE(3, k3, v3);
    if (lat) { GQ_GLOAD(4, k0, v0); GQ_GLOAD(5, k1, v1); GQ_GLOAD(6, k2, v2); GQ_GLOAD(7, k3, v3); }
    __syncthreads();
    GQ_TILES(0, 4);
    if (lat) {
        GQ_LWRITE(4, k0, v0); GQ_LWRITE(5, k1, v1); GQ_LWRITE(6, k2, v2); GQ_LWRITE(7, k3, v3);
        GQ_GLOAD(8, k0, v0);
        __syncthreads();
        GQ_TILES(4, nt < 8 ? nt : 8);
        if (nt > 8) { GQ_LWRITE(0, k0, v0); __syncthreads(); GQ_TILES(8, 9); }
    }
    __syncthreads();
#undef GQ_GLOAD
#undef GQ_LWRITE
#undef GQ_TILES
    attn_store(o0, o1, l2.x + l2.y, h, MIX + (size_t)qrow * DM + 64 * head);
}
constexpr int MLA_KP = 104, MLA_VP = 72, MLA_BUF = 64 * MLA_KP * 2 + 64 * MLA_VP * 2;
DI void mla_unit(const Args& a, int u, unsigned char* lds) {
    const int tid = mk_otid(), lane = tid & 63, wave = __builtin_amdgcn_readfirstlane(tid >> 6), r = lane & 31, h = lane >> 5;
    const bf16_t* P = (const bf16_t*)(a.ws + WS_P); const bf16_t* QU = (const bf16_t*)(a.ws + WS_QU); const bf16_t* KN = (const bf16_t*)(a.ws + WS_KN); const bf16_t* VT = (const bf16_t*)(a.ws + WS_VT);
    const f32x2* RM = (const f32x2*)(a.ws + WS_ROPM); bf16_t* MIX = (bf16_t*)(a.ws + WS_MIX);
    const float sl2 = 0.10206207261596577f * LOG2E;
    const bool lat = u < 256; const int uu = lat ? u : u - 256;
    const int b = lat ? (uu >> 7) : (uu >> 3), head = lat ? ((uu >> 4) & 7) : (uu & 7), qb = lat ? (uu & 15) : 0;
    const int t0 = 256 * qb + 32 * wave, qrow = (lat ? 4096 * b : NLAT + 256 * b) + t0 + r;
    bf16x8 qf[6];
#pragma unroll
    for (int s = 0; s < 6; ++s) qf[s] = *(const bf16x8*)(QU + (size_t)qrow * 768 + 96 * head + 16 * s + 8 * h);
    if (lat) {
        const int pos = t0 + r;
#pragma unroll
        for (int part = 0; part < 2; ++part) { u32x4 o; const u32x4 qv = __builtin_bit_cast(u32x4, qf[4 + part]);
#pragma unroll
            for (int w = 0; w < 4; ++w) { const float own0 = bf2f(qv[w] & 0xffffu), own1 = bf2f(qv[w] >> 16); const float oth0 = mk_shx(own0, 32), oth1 = mk_shx(own1, 32);
                const f32x2 cs0 = RM[pos * 16 + part * 8 + 2 * w], cs1 = RM[pos * 16 + part * 8 + 2 * w + 1];
                const float r0 = own0 * cs0.x + (h ? oth0 : -oth0) * cs0.y, r1 = own1 * cs1.x + (h ? oth1 : -oth1) * cs1.y; o[w] = pk2(r0, r1); }
            qf[4 + part] = __builtin_bit_cast(bf16x8, o); }
    }
    f32x16 o0 = zero16(), o1 = zero16(); f32x2 l2 = {0.f, 0.f}; float m = -1024.0f;
    const int nt = lat ? 68 : 4;
    const int lkey = tid >> 3, lch = tid & 7, rkey = (tid >> 2) & 63, rch = tid & 3;
    u32x4 gk, gr = {0u, 0u, 0u, 0u}, gv;
#define MLA_GLOAD(tn_) do { const int tc_ = (tn_) < nt ? (tn_) : nt - 1; const int krow0_ = lat ? (tc_ < 64 ? 4096 * b + 64 * tc_ : NLAT + 256 * b + 64 * (tc_ - 64)) : NLAT + 256 * b + 64 * tc_; \
        gk = *(const u32x4*)(KN + (size_t)(krow0_ + lkey) * 512 + 64 * head + 8 * lch); \
        if (tid < 256) gr = *(const u32x4*)(P + (size_t)(krow0_ + rkey) * INP + OFF_DKR + 8 * rch); \
        gv = *(const u32x4*)(VT + (size_t)(64 * head + lkey) * MROWS + krow0_ + 8 * lch); } while (0)
#define MLA_LWRITE(slot_) do { bf16_t* Kn_ = (bf16_t*)(lds + (slot_) * MLA_BUF); bf16_t* Vn_ = Kn_ + 64 * MLA_KP; \
        *(u32x4*)(Kn_ + lkey * MLA_KP + 8 * lch) = gk; if (tid < 256) *(u32x4*)(Kn_ + rkey * MLA_KP + 64 + 8 * rch) = gr; \
        { bf16_t* vd_ = Vn_ + lkey * MLA_VP + 16 * (lch >> 1) + 4 * (lch & 1); *(u32x2*)vd_ = (u32x2){gv.x, gv.y}; *(u32x2*)(vd_ + 8) = (u32x2){gv.z, gv.w}; } } while (0)
#define MLA_QK(kp0_, N0, N1, sa_, sb_) do { _Pragma("unroll") for (int s = (sa_); s < (sb_); ++s) { const bf16x8 qq_ = qf[s]; \
        N0 = MFMA32(*(const bf16x8*)((kp0_) + 16 * s), qq_, N0); N1 = MFMA32(*(const bf16x8*)((kp0_) + 32 * MLA_KP + 16 * s), qq_, N1); } } while (0)
#define MLA_HALF(C0, C1, N0, N1, tcur_) do { \
        const int s1_ = slot == 2 ? 0 : slot + 1, s2_ = s1_ == 2 ? 0 : s1_ + 1; \
        MLA_GLOAD((tcur_) + 2); \
        const bf16_t* kn_ = (const bf16_t*)(lds + s1_ * MLA_BUF) + r * MLA_KP + 8 * h; \
        const bf16_t* vp_ = (const bf16_t*)(lds + slot * MLA_BUF) + 64 * MLA_KP + r * MLA_VP + 8 * h; \
        { const float nm_ = -m; _Pragma("unroll") for (int reg = 0; reg < 16; ++reg) { N0[reg] = nm_; N1[reg] = nm_; } }        \
        MLA_QK(kn_, N0, N1, 0, 2); \
        int ti_ = (int)0x80000000; \
        _Pragma("unroll") for (int reg = 0; reg < 16; ++reg) ti_ = imax3(ti_, __float_as_int(C0[reg]), __float_as_int(C1[reg])); \
        { const auto rr_ = __builtin_amdgcn_permlane32_swap((unsigned)ti_, (unsigned)ti_, false, false); const int a_ = (int)rr_[0], b_ = (int)rr_[1]; ti_ = a_ > b_ ? a_ : b_; } \
        const float tmax_ = __int_as_float(ti_); \
        if (__any(tmax_ > 8.0f)) { \
            const float mn_ = tmax_ > 8.0f ? m + tmax_ : m, d_ = mn_ - m, alpha_ = __builtin_amdgcn_exp2f(-d_); m = mn_; \
            _Pragma("unroll") for (int reg = 0; reg < 16; ++reg) { o0[reg] *= alpha_; o1[reg] *= alpha_; C0[reg] -= d_; C1[reg] -= d_; N0[reg] -= d_; N1[reg] -= d_; } l2 *= alpha_;        \
        } \
        MLA_QK(kn_, N0, N1, 2, 6); \
        _Pragma("unroll") for (int reg = 0; reg < 16; ++reg) { C0[reg] = __builtin_amdgcn_exp2f(C0[reg]); C1[reg] = __builtin_amdgcn_exp2f(C1[reg]); } \
        _Pragma("unroll") for (int reg = 0; reg < 16; reg += 2) { l2 += (f32x2){C0[reg], C0[reg + 1]}; l2 += (f32x2){C1[reg], C1[reg + 1]}; } \
        { const bf16x8 pa0 = pack8(C0, 0), pa1 = pack8(C0, 1), pb0 = pack8(C1, 0), pb1 = pack8(C1, 1); \
          o0 = MFMA32(*(const bf16x8*)(vp_), pa0, o0);      o1 = MFMA32(*(const bf16x8*)(vp_ + 32 * MLA_VP), pa0, o1); \
          o0 = MFMA32(*(const bf16x8*)(vp_ + 16), pa1, o0); o1 = MFMA32(*(const bf16x8*)(vp_ + 32 * MLA_VP + 16), pa1, o1); \
          o0 = MFMA32(*(const bf16x8*)(vp_ + 32), pb0, o0); o1 = MFMA32(*(const bf16x8*)(vp_ + 32 * MLA_VP + 32), pb0, o1); \
          o0 = MFMA32(*(const bf16x8*)(vp_ + 48), pb1, o0); o1 = MFMA32(*(const bf16x8*)(vp_ + 32 * MLA_VP + 48), pb1, o1); } \
        MLA_LWRITE(s2_); \
        __syncthreads(); \
        slot = s1_; } while (0)
    MLA_GLOAD(0); MLA_LWRITE(0); MLA_GLOAD(1); MLA_LWRITE(1);
    __syncthreads();
    f32x16 A0, A1, B0, B1;
    { const float nm0 = -m;
#pragma unroll
      for (int reg = 0; reg < 16; ++reg) { A0[reg] = nm0; A1[reg] = nm0; }
      const bf16_t* k0_ = (const bf16_t*)lds + r * MLA_KP + 8 * h; MLA_QK(k0_, A0, A1, 0, 6); }
    int slot = 0;
#pragma unroll 1
    for (int t = 0; t < nt; t += 2) {
        MLA_HALF(A0, A1, B0, B1, t);
        MLA_HALF(B0, B1, A0, A1, t + 1);
    }
#undef MLA_GLOAD
#undef MLA_LWRITE
#undef MLA_QK
#undef MLA_HALF
    attn_store(o0, o1, l2.x + l2.y, h, MIX + (size_t)qrow * DM + 1536 + 64 * head);
}

#ifndef MK_REP_MASK
#define MK_REP_MASK 0
#endif
#define HREP(k) for (int hrep_ = 0; hrep_ < 1 + (((MK_REP_MASK) >> (k)) & 1); ++hrep_)
constexpr int HY_CST = 8224;
constexpr int HY_ZB = 5120;
DI int zoff(int t) { return (t >> 5) * 40 + (t & 31); }
DI int yoff(int t) { return t + (t >> 6) * 4; }
DI void hyena_lat_unit(const Args& a, int layer, int c, unsigned char* lds) {
    const int tid = mk_otid(), lane = tid & 63, wave = __builtin_amdgcn_readfirstlane(tid >> 6), r = lane & 31, h = lane >> 5;
    bf16_t* FC = (bf16_t*)lds; bf16_t* ZA = (bf16_t*)(lds + 65792); bf16_t* ZB = (bf16_t*)(lds + 86272); bf16_t* ZZ = (bf16_t*)(lds + 106752); bf16_t* X1 = (bf16_t*)(lds + 106912); bf16_t* X2 = (bf16_t*)(lds + 123296);
    float* Y = (float*)lds;
    const bf16_t* PT2 = (const bf16_t*)(a.ws + WS_PT2); bf16_t* HT = (bf16_t*)(a.ws + WS_HT) + (size_t)c * MROWS;
    const float* sw = a.in[13] + layer * 3 * 1536;
    if (tid < 80) ZZ[tid] = 0;
    u32x4 fr0, fr1;
    { const bf16_t* F0 = (const bf16_t*)(a.ws + WS_FILT) + ((size_t)(layer * 2) * 512 + c) * 8192; fr0 = *(const u32x4*)(F0 + 8 * tid); fr1 = *(const u32x4*)(F0 + 8 * (tid + 512)); }
    u32x4 pvs[6]; unsigned short lft[6], rgt[6];
#pragma unroll
    for (int it = 0; it < 6; ++it) { const int idx = tid + 512 * it, part = idx >> 10, bb = (idx >> 9) & 1, t0 = 8 * (idx & 511);
        const bf16_t* src = PT2 + (size_t)(128 + part * 512 + c) * MROWS + bb * 4096;
        pvs[it] = *(const u32x4*)(src + t0); lft[it] = t0 > 0 ? (unsigned short)src[t0 - 1] : (unsigned short)0; rgt[it] = t0 + 8 < 4096 ? (unsigned short)src[t0 + 8] : (unsigned short)0; }
    HREP(20)
#pragma unroll
    for (int it = 0; it < 6; ++it) { const int idx = tid + 512 * it, part = idx >> 10, bb = (idx >> 9) & 1, t0 = 8 * (idx & 511);
        const u32x4 pv = pvs[it]; const float left = bf2f(lft[it]), right = bf2f(rgt[it]);
        const float w0 = sw[part * 512 + c], w1 = sw[1536 + part * 512 + c], w2 = sw[3072 + part * 512 + c];
        float p[10]; p[0] = left; p[9] = right;
#pragma unroll
        for (int e = 0; e < 4; ++e) { p[1 + 2 * e] = bf2f(pv[e] & 0xffffu); p[2 + 2 * e] = bf2f(pv[e] >> 16); }
        u32x4 o;
#pragma unroll
        for (int e = 0; e < 4; ++e) o[e] = pk2(w0 * p[2 * e] + w1 * p[2 * e + 1] + w2 * p[2 * e + 2], w0 * p[2 * e + 1] + w1 * p[2 * e + 2] + w2 * p[2 * e + 3]);
        bf16_t* dst = part == 0 ? ZA + bb * HY_ZB + zoff(t0) : (part == 1 ? X1 : X2) + bb * 4096 + t0;
        *(u32x4*)dst = o; }
    const int ct = wave & 1, dq = wave >> 1, I = 32 * ct + r;
    const int dstart = 32 * ct - 63 + 24 * dq, nd = dq < 3 ? 24 : 23;
#pragma unroll 1
    for (int o = 0; o < 2; ++o) {
        const bf16_t* F = (const bf16_t*)(a.ws + WS_FILT) + ((size_t)(layer * 2 + o) * 512 + c) * 8192;
        __syncthreads();
        *(u32x4*)(FC + 8 * tid) = fr0; *(u32x4*)(FC + 8 * (tid + 512)) = fr1;
        if (o == 0) { fr0 = *(const u32x4*)(F + (size_t)512 * 8192 + 8 * tid); fr1 = *(const u32x4*)(F + (size_t)512 * 8192 + 8 * (tid + 512)); }
        if (tid < 4) *(u32x2*)(FC + 8192 + 4 * tid) = (u32x2){0u, 0u};
        __syncthreads();
        for (int i = tid; i < 3 * 2050; i += 512) { const int sg = 1 + i / 2050, x = 4 * (i % 2050);
            const unsigned long long lo = *(const unsigned long long*)(FC + x), hi = *(const unsigned long long*)(FC + x + 4);
            *(unsigned long long*)(FC + sg * HY_CST + x) = (lo >> (16 * sg)) | (hi << (64 - 16 * sg)); }
        __syncthreads();
        const bf16_t* zin = o ? ZB : ZA;
        const float bias = a.in[20][(layer * 2 + o) * 512 + c], inrm = 1.0f / ((const float*)(a.ws + WS_FNORM))[(layer * 2 + o) * 512 + c];
        f32x16 a00 = zero16(), a01 = zero16(), a10 = zero16(), a11 = zero16();
        HREP(21) { a00 = zero16(); a01 = zero16(); a10 = zero16(); a11 = zero16();
        {   const int sg = (4096 - r) & 3;
            const bf16_t* ap = FC + sg * HY_CST + (4096 - r - sg + 8 * h) - 64 * dstart;
#define HY_LOAD(dd_, PM32, PM16, P0, P16, BA0, BA1, BA2, BA3, BB0, BB1, BB2, BB3) do { const int ddc_ = (dd_) < nd ? (dd_) : nd - 1; \
                const int blk_ = I - (dstart + ddc_); const bool valid_ = (unsigned)blk_ < 64u; \
                const bf16_t* zp0_ = (valid_ ? zin + 80 * blk_ : ZZ) + 8 * h; const bf16_t* zp1_ = (valid_ ? zin + HY_ZB + 80 * blk_ : ZZ) + 8 * h; \
                const bf16_t* ad_ = ap - 64 * ddc_; \
                PM32 = ld2x8(ad_ - 32, ad_ - 28); PM16 = ld2x8(ad_ - 16, ad_ - 12); P0 = ld2x8(ad_, ad_ + 4); P16 = ld2x8(ad_ + 16, ad_ + 20); \
                BA0 = *(const bf16x8*)(zp0_); BA1 = *(const bf16x8*)(zp0_ + 16); BA2 = *(const bf16x8*)(zp0_ + 40); BA3 = *(const bf16x8*)(zp0_ + 56); \
                BB0 = *(const bf16x8*)(zp1_); BB1 = *(const bf16x8*)(zp1_ + 16); BB2 = *(const bf16x8*)(zp1_ + 40); BB3 = *(const bf16x8*)(zp1_ + 56); } while (0)
#define HY_MMA(PM32, PM16, P0, P16, BA0, BA1, BA2, BA3, BB0, BB1, BB2, BB3) do { \
                a00 = MFMA32(P0, BA0, a00); a01 = MFMA32(P0, BB0, a01); a10 = MFMA32(PM32, BA0, a10); a11 = MFMA32(PM32, BB0, a11); \
                a00 = MFMA32(P16, BA1, a00); a01 = MFMA32(P16, BB1, a01); a10 = MFMA32(PM16, BA1, a10); a11 = MFMA32(PM16, BB1, a11); \
                a00 = MFMA32(c32, BA2, a00); a01 = MFMA32(c32, BB2, a01); a10 = MFMA32(P0, BA2, a10); a11 = MFMA32(P0, BB2, a11); \
                a00 = MFMA32(c48, BA3, a00); a01 = MFMA32(c48, BB3, a01); a10 = MFMA32(P16, BA3, a10); a11 = MFMA32(P16, BB3, a11); \
                c32 = PM32; c48 = PM16; } while (0)
#define HY_ILV do { _Pragma("unroll") for (int i_ = 0; i_ < 16; ++i_) { __builtin_amdgcn_sched_group_barrier(0x008, 1, 0); __builtin_amdgcn_sched_group_barrier(0x100, 1, 0); } } while (0)
            bf16x8 c32 = ld2x8(ap + 32, ap + 36), c48 = ld2x8(ap + 48, ap + 52);
            bf16x8 e0, e1, e2, e3, e4, e5, e6, e7, e8, e9, e10, e11, f0, f1, f2, f3, f4, f5, f6, f7, f8, f9, f10, f11;
            HY_LOAD(0, e0, e1, e2, e3, e4, e5, e6, e7, e8, e9, e10, e11);
#pragma unroll 1
            for (int dd = 0; dd < nd; dd += 2) {
                HY_LOAD(dd + 1, f0, f1, f2, f3, f4, f5, f6, f7, f8, f9, f10, f11);
                HY_MMA(e0, e1, e2, e3, e4, e5, e6, e7, e8, e9, e10, e11);
                HY_ILV;
                if (dd + 1 < nd) {
                    HY_LOAD(dd + 2, e0, e1, e2, e3, e4, e5, e6, e7, e8, e9, e10, e11);
                    HY_MMA(f0, f1, f2, f3, f4, f5, f6, f7, f8, f9, f10, f11);
                    HY_ILV;
                }
            }
#undef HY_LOAD
#undef HY_ILV
#undef HY_MMA
        }
        asm volatile("" : "+v"(a00), "+v"(a01), "+v"(a10), "+v"(a11)); }
        __syncthreads();
#pragma unroll 1
        for (int k = 0; k < 4; ++k) {
            if (dq == k) {
#pragma unroll
                for (int g4 = 0; g4 < 4; ++g4) { const int tb = 64 * I + 8 * g4 + 4 * h;
                    float* y00 = Y + yoff(tb), *y10 = Y + yoff(tb + 32), *y01 = y00 + 4352, *y11 = y10 + 4352;
                    f32x4 v00 = {a00[4 * g4], a00[4 * g4 + 1], a00[4 * g4 + 2], a00[4 * g4 + 3]}, v01 = {a01[4 * g4], a01[4 * g4 + 1], a01[4 * g4 + 2], a01[4 * g4 + 3]};
                    f32x4 v10 = {a10[4 * g4], a10[4 * g4 + 1], a10[4 * g4 + 2], a10[4 * g4 + 3]}, v11 = {a11[4 * g4], a11[4 * g4 + 1], a11[4 * g4 + 2], a11[4 * g4 + 3]};
                    if (k > 0) { v00 += *(const f32x4*)y00; v01 += *(const f32x4*)y01; v10 += *(const f32x4*)y10; v11 += *(const f32x4*)y11; }
                    *(f32x4*)y00 = v00; *(f32x4*)y01 = v01; *(f32x4*)y10 = v10; *(f32x4*)y11 = v11; }
            }
            __syncthreads();
        }
#pragma unroll
        for (int k = 0; k < 4; ++k) { const int q = tid + 512 * k, bb = q >> 10, t0 = 4 * (q & 1023);
            const f32x4 yv = *(const f32x4*)(Y + bb * 4352 + yoff(t0));
            const u32x2 zp = *(const u32x2*)(zin + bb * HY_ZB + zoff(t0)), xg = *(const u32x2*)((o ? X2 : X1) + bb * 4096 + t0);
            const float z[4] = {bf2f(zp.x & 0xffffu), bf2f(zp.x >> 16), bf2f(zp.y & 0xffffu), bf2f(zp.y >> 16)}, xv[4] = {bf2f(xg.x & 0xffffu), bf2f(xg.x >> 16), bf2f(xg.y & 0xffffu), bf2f(xg.y >> 16)};
            float y[4];
#pragma unroll
            for (int e = 0; e < 4; ++e) y[e] = xv[e] * (yv[e] * inrm + bias * z[e]);
            u32x2 w; w.x = pk2(y[0], y[1]); w.y = pk2(y[2], y[3]);
            if (o == 0) *(u32x2*)(ZB + bb * HY_ZB + zoff(t0)) = w; else *(u32x2*)(HT + bb * 4096 + t0) = w; }
    }
    __syncthreads();
}
DI void hyena_ctx_unit(const Args& a, int layer, int c, unsigned char* lds) {
    const int tid = mk_otid(), bb = tid >> 8, t = tid & 255;
    float* G0 = (float*)lds; float* G1 = G0 + 640; float* zv = G0 + 1280; float* x1 = G0 + 1792; float* x2 = G0 + 2304; float* z1 = G0 + 2816; float* part = G0 + 3328;
    const bf16_t* PT2 = (const bf16_t*)(a.ws + WS_PT2); bf16_t* HT = (bf16_t*)(a.ws + WS_HT) + (size_t)c * MROWS;
    const float* FCX = (const float*)(a.ws + WS_FILTC); const float* sw = a.in[13] + layer * 3 * 1536;
    const float* FN = (const float*)(a.ws + WS_FNORM) + (4 + layer) * 2 * 512;
    G0[tid + (tid >> 2)] = FCX[((size_t)(layer * 2 + 0) * 512 + c) * 512 + tid]; G1[tid + (tid >> 2)] = FCX[((size_t)(layer * 2 + 1) * 512 + c) * 512 + tid];
    const float fn0 = FN[c], fn1 = FN[512 + c], hb0 = a.in[20][(layer * 2 + 0) * 512 + c], hb1 = a.in[20][(layer * 2 + 1) * 512 + c];
    float uo[3];
#pragma unroll
    for (int part_ = 0; part_ < 3; ++part_) { const bf16_t* src = PT2 + (size_t)(128 + part_ * 512 + c) * MROWS + NLAT + 256 * bb;
        const float pm1 = t > 0 ? bf2f(src[t - 1]) : 0.f, p0 = bf2f(src[t]), pp1 = t < 255 ? bf2f(src[t + 1]) : 0.f;
        uo[part_] = sw[part_ * 512 + c] * pm1 + sw[1536 + part_ * 512 + c] * p0 + sw[3072 + part_ * 512 + c] * pp1; }
    zv[tid] = uo[0]; x1[tid] = uo[1]; x2[tid] = uo[2];
    const int sh = tid >> 7, b2 = (tid >> 6) & 1, t4 = 4 * (tid & 63);
#pragma unroll 1
    for (int o = 0; o < 2; ++o) {
        __syncthreads();
        const float* Gf = o ? G1 : G0; const float* zz = (o ? z1 : zv) + b2 * 256;
        float y0 = 0.f, y1 = 0.f, y2 = 0.f, y3 = 0.f;
        const int s_lo = 64 * sh;
#pragma unroll 4
        for (int s = s_lo; s < s_lo + 64; s += 4) { const f32x4 z4 = *(const f32x4*)(zz + s); const int x0 = 256 - t4 + s - 3; const float* gp = Gf + x0 + (x0 >> 2);
            const float g0 = gp[0], g1 = gp[1], g2 = gp[2], g3 = gp[4], g4 = gp[5], g5 = gp[6], g6 = gp[7];
            y0 += g3 * z4[0] + g4 * z4[1] + g5 * z4[2] + g6 * z4[3];
            y1 += g2 * z4[0] + g3 * z4[1] + g4 * z4[2] + g5 * z4[3];
            y2 += g1 * z4[0] + g2 * z4[1] + g3 * z4[2] + g4 * z4[3];
            y3 += g0 * z4[0] + g1 * z4[1] + g2 * z4[2] + g3 * z4[3]; }
        *(f32x4*)(part + sh * 512 + b2 * 256 + t4) = (f32x4){y0, y1, y2, y3};
        __syncthreads();
        const float y = ((part[tid] + part[512 + tid]) + (part[1024 + tid] + part[1536 + tid])) / (o ? fn1 : fn0);
        if (o == 0) z1[tid] = uo[1] * (y + hb0 * uo[0]);
        else HT[NLAT + 256 * bb + t] = f2bf(uo[2] * (y + hb1 * z1[tid]));
    }
    __syncthreads();
}

constexpr int PH_PRO_A = 0, PH_PRO_B = 1, PH_L0 = 2, PH_PER_LAYER = 11, N_PHASES = PH_L0 + DEPTH * PH_PER_LAYER;
__host__ __device__ inline bool phase_active(int ph) {
    if (ph < PH_L0) return true;
    const int layer = (ph - PH_L0) / PH_PER_LAYER, k = (ph - PH_L0) % PH_PER_LAYER;
    if (k == 0) return layer == 0;
    if (k == 7) return (layer & 1) != 0;
    return true;
}

__global__ void __launch_bounds__(512, 2) mega(Args a) {
    extern __shared__ __attribute__((aligned(16))) unsigned char lds[];
    const int tid = mk_otid(), G = gridDim.x;
    PG8_LAS unsigned char* ldsl = (PG8_LAS unsigned char*)lds;
    volatile LAS unsigned* MISC = (volatile LAS unsigned*)(ldsl + MISC_OFF);
    if (tid < 64) MISC[tid] = 0u;
    __syncthreads();
    unsigned char* ws = a.ws;
    XcdBarrier bar = xcd_barrier_post((unsigned*)(ws + WS_CTL) + CW_BAR, MISC);
    const int lo = a.ph_lo, hi = a.ph_hi;
#ifndef MK_PHMASK
#define MK_PHMASK 0xffff
#endif
#define EN(k) (((MK_PHMASK) >> (k)) & 1)
#ifndef MK_SUB
#define MK_SUB 0xff
#endif
#define SUB(k) (((MK_SUB) >> (k)) & 1)
#ifndef MK_REP_MASK
#define MK_REP_MASK 0
#endif
#define REP(k) for (int rep_ = 0; rep_ < 1 + (((MK_REP_MASK) >> (k)) & 1); ++rep_)
#define IN(k) (lo <= (k) && (k) < hi)
#define SEAM(k) do { if ((k) + 1 < hi) xcd_barrier(bar); } while (0)
    bf16_t* XB = (bf16_t*)(ws + WS_X);     bf16_t* HA = (bf16_t*)(ws + WS_HA); bf16_t* P = (bf16_t*)(ws + WS_P); bf16_t* MIX = (bf16_t*)(ws + WS_MIX); bf16_t* Y = (bf16_t*)(ws + WS_Y);
    const float* MOD = (const float*)(ws + WS_MOD);

    if (EN(11) && IN(PH_PRO_A)) { REP(11) phase_pro_a(a, lds); SEAM(PH_PRO_A); }
    if (EN(12) && IN(PH_PRO_B)) { REP(12) phase_pro_b(a, lds); SEAM(PH_PRO_B); }

#pragma unroll 1
    for (int layer = 0; layer < DEPTH; ++layer) {
        const int pb = PH_L0 + layer * PH_PER_LAYER;
        if (pb + PH_PER_LAYER <= lo || pb >= hi) continue;
        const bool ctx_out = layer < DEPTH - 1, moe = (layer & 1) != 0;
        const int nrows = ctx_out ? MROWS : NLAT;
        const float* modl = MOD + (size_t)layer * 3 * 12288;
        asm volatile("; MKPHASE 0" ::: "memory");
        if (EN(0) && IN(pb + 0) && layer == 0) {
            NormP p{}; p.xin_lat = a.in[0]; p.xin_ctx = a.in[2]; p.nrows = MROWS; p.mod_shift = modl; p.mod_scale = modl + 2048; p.gpre = a.in[6]; p.ha = HA;
            norm_phase<false, false, true, false, false>(p, lds); SEAM(pb + 0);
        }
        asm volatile("; MKPHASE 1" ::: "memory");
        if (EN(1) && IN(pb + 1)) {
            REP(1) {
            pg8::Gemm g{HA, (const bf16_t*)(ws + WS_WIN) + (size_t)layer * INP * DM, MROWS, INP, DM}; pg8::StaticOrder S; S.init(MROWS, INP, G, (int)blockIdx.x);
            pg8::EpiStore E{P, INP, 1 << 20};
            pg8::gemm_phase<pg8::EpiStore, pg8::StaticOrder, true, true>(ldsl, g, S, E);
            }
            SEAM(pb + 1);
        }
        asm volatile("; MKPHASE 2" ::: "memory");
        if (EN(2) && IN(pb + 2)) {
            REP(17) { for (int u = blockIdx.x; u < 8 * NCHK; u += G) mlstm_step1_unit(a, layer, u, lds); }
            { const bool full = G == 256; const int vb = full ? (int)blockIdx.x - 16 : -1, vg = 240;
              if (!full || vb >= 0) {
                REP(18) task_transpose((const bf16_t*)(ws + WS_P) + OFF_AV, INP, (bf16_t*)(ws + WS_PT2), MROWS, 136, 26, lds, vb, vg);
                task_rope(a, vb, vg);
                REP(18) task_mla_norm(a, layer, vb, vg); } }
            SEAM(pb + 2);
        }
        asm volatile("; MKPHASE 3" ::: "memory");
        if (EN(3) && IN(pb + 3)) {
            REP(3) {
            if (SUB(0)) {
                const int mq = ctx_out ? MROWS : NLAT, nuq = (mq / 256) * 3;
                const bf16_t* wkv = (const bf16_t*)(ws + WS_WUKV) + (size_t)layer * 1024 * 256;
                pg8::Gemm gq{(const bf16_t*)(ws + WS_QN), (const bf16_t*)(ws + WS_WUQ) + (size_t)layer * 768 * 512, mq, 768, 512}; pg8::StaticOrder Sq; Sq.init(mq, 768, G, (int)blockIdx.x);
                pg8::EpiStore Eq{(bf16_t*)(ws + WS_QU), 768, 1 << 20};
                pg8::gemm_phase<pg8::EpiStore, pg8::StaticOrder, true, true>(ldsl, gq, Sq, Eq);
                pg8::Gemm gk{(const bf16_t*)(ws + WS_KVN), wkv, MROWS, 512, 256}; pg8::StaticOrder Sk; Sk.init(MROWS, 512, G, (int)((blockIdx.x + G - nuq) % G));
                pg8::EpiStore Ek{(bf16_t*)(ws + WS_KN), 512, 1 << 20};
                pg8::gemm_phase<pg8::EpiStore, pg8::StaticOrder, true, true>(ldsl, gk, Sk, Ek);
                pg8::Gemm gv{wkv + (size_t)512 * 256, (const bf16_t*)(ws + WS_KVN), 512, MROWS, 256}; pg8::StaticOrder Sv; Sv.init(512, MROWS, G, (int)((blockIdx.x + 2 * G - nuq - 68) % G));
                pg8::EpiStore Ev{(bf16_t*)(ws + WS_VT), MROWS, 1 << 20};
                pg8::gemm_phase<pg8::EpiStore, pg8::StaticOrder, true, true>(ldsl, gv, Sv, Ev);
            }
            __syncthreads();
            if (SUB(1)) REP(13) for (int c = blockIdx.x; c < 512; c += G) hyena_lat_unit(a, layer, c, lds);
            if (SUB(2) && ctx_out) for (int c = blockIdx.x; c < 512; c += G) hyena_ctx_unit(a, layer, c, lds);
            if (SUB(3)) REP(14) { const int bx = (int)blockIdx.x, xc = bx & 7, li = bx >> 3;
              if (G == 256) { gqa_unit(a, layer, (xc >> 1) * 64 + (xc & 1) * 32 + li, lds); if (ctx_out && bx >= 240) gqa_unit(a, layer, 256 + (xc >> 1) * 4 + (xc & 1) * 2 + (li - 30), lds); }
              else { for (int u = bx; u < 256; u += G) gqa_unit(a, layer, u, lds); if (ctx_out) for (int u = 256 + bx; u < 272; u += G) gqa_unit(a, layer, u, lds); } }
            if (SUB(4)) REP(19) task_mlstm_scan(a);
            }
            SEAM(pb + 3);
        }
        asm volatile("; MKPHASE 4" ::: "memory");
        if (EN(4) && IN(pb + 4)) {
            REP(4) {
            REP(15) for (int u = blockIdx.x; u < 8 * NCHK; u += G) { if (!ctx_out && (u % NCHK) < 2) continue; mlstm_step3_unit(a, layer, u, lds); }
            { const bool two = G == 256 && ctx_out;
              if (!two || blockIdx.x >= 16) task_transpose((const bf16_t*)(ws + WS_HT), MROWS, MIX + 512, DM, 8, nrows / 64, lds, two ? (int)blockIdx.x - 16 : -1, 240); }
            __syncthreads();
            REP(16) { const int bx = (int)blockIdx.x, li = bx >> 3, pr = 2 * (bx & 7) + (li >> 4);
              if (G == 256) { mla_unit(a, pr * 16 + (li & 15), lds); if (ctx_out && bx >= 16 && bx < 32) mla_unit(a, 256 + 2 * (bx & 7) + ((bx >> 3) & 1), lds); }
              else { for (int u = bx; u < 256; u += G) mla_unit(a, u, lds); if (ctx_out) for (int u = 256 + bx; u < 272; u += G) mla_unit(a, u, lds); } }
            }
            SEAM(pb + 4);
        }
        asm volatile("; MKPHASE 5" ::: "memory");
        if (EN(5) && IN(pb + 5)) {
            REP(5) {
            const bf16_t* wo = (const bf16_t*)(ws + WS_WOUT) + (size_t)layer * DM * DM;
            { pg8::Gemm g{MIX, wo, NLAT, DM, DM, 0}; pg8::StaticOrder S; S.init(NLAT, DM, G, (int)blockIdx.x);
              pg8::EpiStore E{Y, DM, 1 << 20, 0};
              pg8::gemm_phase<pg8::EpiStore, pg8::StaticOrder, true, true>(ldsl, g, S, E); }
            if (ctx_out) { pg8::Gemm g{MIX + (size_t)NLAT * DM, wo, NCTX, DM, 256, DM}; pg8::SplitOrder S{2, 8, 8, 256 * 2, G, (int)blockIdx.x};
              pg8::EpiStore E{(bf16_t*)(ws + WS_YC), DM, 1 << 20, (size_t)NCTX * DM};
              pg8::gemm_phase<pg8::EpiStore, pg8::SplitOrder, false, true>(ldsl, g, S, E); }
            }
            SEAM(pb + 5);
        }
        asm volatile("; MKPHASE 6" ::: "memory");
        if (EN(6) && IN(pb + 6)) {
            NormP p{}; p.xin_lat = layer == 0 ? a.in[0] : (const float*)XB; p.xin_ctx = layer == 0 ? a.in[2] : (const float*)(XB + (size_t)NLAT * DM); p.xout_lat = (float*)XB; p.xout_ctx = (float*)(XB + (size_t)NLAT * DM); p.nrows = nrows; p.xin_b16 = layer != 0; p.xout_b16 = 1;
            p.ysrc = Y; p.yctx = (const bf16_t*)(ws + WS_YC); p.nsc = 8; p.mod_gate = modl + 2 * 2048; p.gpost = a.in[7] + layer * DM; p.mod_shift = modl + 3 * 2048; p.mod_scale = modl + 4 * 2048; p.gpre = a.in[8] + layer * DM; p.ha = HA;
            if (moe) { p.router = a.in[30] + (size_t)(layer >> 1) * DM * 8; p.route_out = (f32x4*)(ws + WS_ROUTE); p.hist_out = (int*)(ws + WS_HIST); }
            p.ha8 = 1;
            REP(6) { NormP q = p; if (((MK_REP_MASK) >> 6) & 1) { if (rep_ == 0) { q.xout_lat = (float*)(ws + WS_YS); q.xout_ctx = (float*)((bf16_t*)(ws + WS_YS) + (size_t)NLAT * DM); } }
              if (moe) norm_phase<true, false, true, true, true>(q, lds); else if (layer == 0) norm_phase<true, false, true, false, false>(q, lds); else norm_phase<true, false, true, false, true>(q, lds); }
            SEAM(pb + 6);
        }
        asm volatile("; MKPHASE 7" ::: "memory");
        if (EN(7) && IN(pb + 7) && moe) { phase_gather(a, nrows, lds); SEAM(pb + 7); }
        asm volatile("; MKPHASE 8" ::: "memory");
        if (EN(8) && IN(pb + 8)) {
            REP(8) {
            if (moe) {
                pg8::GroupedOrder S; moe_tiles(a, lds, S); S.nN = 22; S.nwg = S.nM * 22; S.G = G; S.c = (int)blockIdx.x;
                pg8::Gemm g{(const bf16_t*)(ws + WS_HG), (const bf16_t*)(ws + WS_WGUE + (size_t)(layer >> 1) * 8 * 2 * EXPD * DM), 0, 0, DM, 0, SC_H8, SC_W8};
                pg8::EpiSwiGLU E{(bf16_t*)(ws + WS_H), EXPD, 22, 1};
                pg8::gemm_phase<pg8::EpiSwiGLU, pg8::GroupedOrder, true, true, 1>(ldsl, g, S, E);
            } else {
                pg8::Gemm g{HA, (const bf16_t*)(ws + WS_WGU + (size_t)(layer >> 1) * 2 * FFN * DM), nrows, 2 * FFN, DM, 0, SC_H8, SC_W8}; pg8::StaticOrder S; S.init(nrows, 2 * FFN, G, (int)blockIdx.x);
                pg8::EpiSwiGLU E{(bf16_t*)(ws + WS_H), FFN, 1 << 20, 1};
                pg8::gemm_phase<pg8::EpiSwiGLU, pg8::StaticOrder, true, true, 1>(ldsl, g, S, E);
            }
            }
            SEAM(pb + 8);
        }
        asm volatile("; MKPHASE 9" ::: "memory");
        if (EN(9) && IN(pb + 9)) {
            REP(9) {
            if (moe) {
                pg8::GroupedOrder S; moe_tiles(a, lds, S); S.nN = 8; S.nwg = S.nM * 8; S.G = G; S.c = (int)blockIdx.x;
                pg8::Gemm g{(const bf16_t*)(ws + WS_H), (const bf16_t*)(ws + WS_WDNE + (size_t)(layer >> 1) * 8 * DM * EXPD), 0, 0, EXPD, 0, SC_H8, SC_W8};
                pg8::EpiStore E{(bf16_t*)(ws + WS_YS), DM, 8};
                pg8::gemm_phase<pg8::EpiStore, pg8::GroupedOrder, true, true, 1>(ldsl, g, S, E);
            } else {
                const bf16_t* wd = (const bf16_t*)(ws + WS_WDN + (size_t)(layer >> 1) * DM * FFN);
                { pg8::Gemm g{(const bf16_t*)(ws + WS_H), wd, NLAT, DM, FFN, 0, SC_H8, SC_W8}; pg8::StaticOrder S; S.init(NLAT, DM, G, (int)blockIdx.x);
                  pg8::EpiStore E{Y, DM, 1 << 20, 0};
                  pg8::gemm_phase<pg8::EpiStore, pg8::StaticOrder, true, true, 1>(ldsl, g, S, E); }
                { pg8::Gemm g{(const bf16_t*)(ws + WS_H + (size_t)NLAT * FFN), wd, NCTX, DM, 512, FFN, SC_H8, SC_W8}; pg8::SplitOrder S{2, 8, 11, 512, G, (int)blockIdx.x};
                  pg8::EpiStore E{(bf16_t*)(ws + WS_YC), DM, 1 << 20, (size_t)NCTX * DM};
                  pg8::gemm_phase<pg8::EpiStore, pg8::SplitOrder, true, true, 1>(ldsl, g, S, E); }
            }
            }
            SEAM(pb + 9);
        }
        asm volatile("; MKPHASE 10" ::: "memory");
        if (EN(10) && IN(pb + 10)) {
            NormP p{}; p.xin_lat = (const float*)XB; p.xin_ctx = (const float*)(XB + (size_t)NLAT * DM); p.xin_b16 = 1; p.nrows = nrows; p.mod_gate = modl + 5 * 2048; p.gpost = a.in[9] + layer * DM;
            if (ctx_out) { p.xout_lat = (float*)XB; p.xout_ctx = (float*)(XB + (size_t)NLAT * DM); p.xout_b16 = 1; const float* modn = modl + 3 * 12288; p.mod_shift = modn; p.mod_scale = modn + 2048; p.gpre = a.in[6] + (layer + 1) * DM; p.ha = HA; }
            else { p.xout_lat = a.out; p.xout_ctx = a.out; }
            if (moe) { p.ysrc = (const bf16_t*)(ws + WS_YS); p.slot = (const int*)(ws + WS_SLOT); p.route = (const f32x4*)(ws + WS_ROUTE);
                if (ctx_out) norm_phase<true, true, true, false>(p, lds); else norm_phase<true, true, false, false>(p, lds); }
            else { p.ysrc = Y; p.yctx = (const bf16_t*)(ws + WS_YC); p.nsc = 11; norm_phase<true, false, true, false>(p, lds); }
            SEAM(pb + 10);
        }
    }
#undef IN
#undef SEAM
}
}

#ifndef MK_ONE_LAUNCH
#define MK_ONE_LAUNCH 1
#endif
extern "C" void kernel_launch(void* const* d_in, const int* in_sizes, int n_in, void* d_out, int out_size, void* d_ws, size_t ws_size, hipStream_t stream) {
    using namespace mk;
    static int grid = 0;
    if (grid == 0) {
        if (n_in != 34 || ws_size < WS_END) { fprintf(stderr, "kernel_launch: expected 34 inputs and >= %zu bytes of workspace; got %d, %zu\n", (size_t)WS_END, n_in, ws_size); grid = -1; return; }
        if (hipFuncSetAttribute((const void*)mega, hipFuncAttributeMaxDynamicSharedMemorySize, LDS_BYTES) != hipSuccess) { fprintf(stderr, "kernel_launch: hipFuncSetAttribute failed\n"); grid = -1; return; }
        int per_cu = 0;
        if (hipOccupancyMaxActiveBlocksPerMultiprocessor(&per_cu, (const void*)mega, 512, LDS_BYTES) != hipSuccess || per_cu < 1) fprintf(stderr, "kernel_launch: occupancy query says %d\n", per_cu);
        (void)hipGetLastError();
        grid = 256;
    }
    if (grid < 0) return;
    (void)hipMemsetAsync((char*)d_ws + WS_CTL, 0, (size_t)(CW_BAR + XCD_BAR_WORDS) * 4, stream);
    Args a{};
    for (int i = 0; i < 34; ++i) a.in[i] = (const float*)d_in[i];
    a.out = (float*)d_out; a.ws = (unsigned char*)d_ws;
#if MK_ONE_LAUNCH
    a.ph_lo = 0; a.ph_hi = N_PHASES;
    hipLaunchKernelGGL(mega, dim3(grid), dim3(512), LDS_BYTES, stream, a);
#else
    for (int ph = 0; ph < N_PHASES; ++ph) { if (!phase_active(ph)) continue; a.ph_lo = ph; a.ph_hi = ph + 1; hipLaunchKernelGGL(mega, dim3(grid), dim3(512), LDS_BYTES, stream, a); }
#endif
}
```
